# Optimizing an MI355X kernel written in HIP

```python
import jax, jax.numpy as jnp
from jax import lax
import numpy as np

D_MODEL = 2048
BATCH = 1
SEQ = 8192
DEPTH = 2

GRID_W = 64
ROPE_THETA = 10000.0
Q_BLOCK = 128
D_MIX = D_MODEL
GQA_HEAD_DIM = 64
GQA_HEADS = (D_MIX // 2) // GQA_HEAD_DIM
GQA_KV_HEADS = GQA_HEADS // 4
MLA_V_DIM = 128
MLA_HEADS = (D_MIX // 4) // MLA_V_DIM
MLA_NOPE_DIM = 128
MLA_ROPE_DIM = 64
MLA_Q_RANK = D_MODEL // 4
MLA_KV_RANK = D_MODEL // 8
MLSTM_HEAD_DIM = 128
MLSTM_HEADS = (D_MIX // 4) // MLSTM_HEAD_DIM
MLSTM_WIDTH = MLSTM_HEADS * MLSTM_HEAD_DIM
MLSTM_CHUNK = 128
CONV_W = 3
DENSE_FF = ((8 * D_MODEL // 3 + 255) // 256) * 256
N_EXPERTS = 8
TOP_K = 2
EXPERT_FF = 7 * D_MODEL // 2
DEEPNORM_ALPHA = (2 * DEPTH) ** 0.25
DEEPNORM_BETA = (8 * DEPTH) ** -0.25
RMS_EPS = 1e-6
LN_EPS = 1e-5
IN_SIZES = (GQA_HEADS * GQA_HEAD_DIM, GQA_KV_HEADS * GQA_HEAD_DIM, GQA_KV_HEADS * GQA_HEAD_DIM,
            MLA_Q_RANK, MLA_KV_RANK, MLA_ROPE_DIM,
            MLSTM_WIDTH, MLSTM_WIDTH, MLSTM_WIDTH, MLSTM_WIDTH, 4 * MLSTM_HEADS)
D_IN = sum(IN_SIZES)
IN_SPLITS = tuple(int(s) for s in np.cumsum(IN_SIZES)[:-1])
MIX_OUT = GQA_HEADS * GQA_HEAD_DIM + MLA_HEADS * MLA_V_DIM + MLSTM_WIDTH

kernel_name = 'hybrid_gqa_mla_mlstm_moe_encoder'


def rms_norm(x, g):
    xf = x.astype(jnp.float32)
    y = xf * lax.rsqrt(jnp.mean(xf * xf, axis=-1, keepdims=True) + RMS_EPS)
    return (y * g.astype(jnp.float32)).astype(x.dtype)


def layer_norm(x, g, b):
    xf = x.astype(jnp.float32)
    mu = jnp.mean(xf, axis=-1, keepdims=True)
    var = jnp.mean(jnp.square(xf - mu), axis=-1, keepdims=True)
    y = (xf - mu) * lax.rsqrt(var + LN_EPS)
    return (y * g.astype(jnp.float32) + b.astype(jnp.float32)).astype(x.dtype)


def axial_rope(seq_len, dim):
    rows = seq_len // GRID_W
    row_pos = jnp.broadcast_to(jnp.arange(rows, dtype=jnp.float32)[:, None], (rows, GRID_W)).reshape(-1)
    col_pos = jnp.broadcast_to(jnp.arange(GRID_W, dtype=jnp.float32)[None, :], (rows, GRID_W)).reshape(-1)
    n_freq = dim // 4
    inv_freq = ROPE_THETA ** (-jnp.arange(n_freq, dtype=jnp.float32) / n_freq)
    ang_r = row_pos[:, None] * inv_freq
    ang_c = col_pos[:, None] * inv_freq
    ang = jnp.concatenate([ang_r, ang_r, ang_c, ang_c], axis=-1)
    return jnp.cos(ang), jnp.sin(ang)


def apply_rope(x, cos, sin):
    xf = x.astype(jnp.float32)
    a1, a2, b1, b2 = jnp.split(xf, 4, axis=-1)
    rot = jnp.concatenate([-a2, a1, -b2, b1], axis=-1)
    return (xf * cos[:, None, :] + rot * sin[:, None, :]).astype(x.dtype)


def blocked_attention(q, k, v):
    B, S, Hk, G, Dq = q.shape
    Dv = v.shape[-1]
    scale = Dq ** -0.5
    qb = jnp.moveaxis(q.reshape(B, S // Q_BLOCK, Q_BLOCK, Hk, G, Dq), 1, 0)

    def one_block(q_blk):
        s = jnp.einsum('bqkgd,bskd->bkgqs', q_blk, k).astype(jnp.float32) * scale
        p = jax.nn.softmax(s, axis=-1).astype(v.dtype)
        return jnp.einsum('bkgqs,bskd->bqkgd', p, v)

    out = lax.map(one_block, qb)
    return jnp.moveaxis(out, 0, 1).reshape(B, S, Hk * G * Dv)


def mlstm_chunkwise(q, k, v, log_i, log_f):
    B, H, S, D = q.shape
    L = MLSTM_CHUNK
    nc = S // L
    q, k, v = (t.reshape(B, H, nc, L, D) for t in (q, k, v))
    li = log_i.reshape(B, H, nc, L)
    b = jnp.cumsum(log_f.reshape(B, H, nc, L), axis=-1)
    g = b[..., -1]
    a = g[..., None] - b + li
    m_loc = jnp.max(a, axis=-1)
    w = jnp.exp(a - m_loc[..., None])
    kv = jnp.einsum('bhcl,bhcld,bhcle->bhcde', w, k, v)
    ks = jnp.einsum('bhcl,bhcld->bhcd', w, k)

    def step(carry, inp):
        C, n, m = carry
        g_c, m_c, kv_c, ks_c = inp
        m_new = jnp.maximum(g_c + m, m_c)
        decay = jnp.exp(g_c + m - m_new)
        add = jnp.exp(m_c - m_new)
        C_new = decay[..., None, None] * C + add[..., None, None] * kv_c
        n_new = decay[..., None] * n + add[..., None] * ks_c
        return (C_new, n_new, m_new), (C, n, m)

    init = (jnp.zeros((B, H, D, D), jnp.float32), jnp.zeros((B, H, D), jnp.float32), jnp.zeros((B, H), jnp.float32))
    xs = tuple(jnp.moveaxis(t, 2, 0) for t in (g, m_loc, kv, ks))
    _, (C_prev, n_prev, m_prev) = lax.scan(step, init, xs)
    C_prev = jnp.moveaxis(C_prev, 0, 2)
    n_prev = jnp.moveaxis(n_prev, 0, 2)
    m_prev = jnp.moveaxis(m_prev, 0, 2)

    lower = jnp.tril(jnp.ones((L, L), dtype=bool))
    log_d = jnp.where(lower, b[..., :, None] - b[..., None, :] + li[..., None, :], -jnp.inf)
    inter = b + m_prev[..., None]
    m_t = jnp.maximum(inter, jnp.max(log_d, axis=-1))
    d_mat = jnp.exp(log_d - m_t[..., None])
    inter_w = jnp.exp(inter - m_t)
    qk = jnp.einsum('bhctd,bhcsd->bhcts', q, k) * d_mat
    num = jnp.einsum('bhcts,bhcsd->bhctd', qk, v) + inter_w[..., None] * jnp.einsum('bhctd,bhcde->bhcte', q, C_prev)
    den = jnp.sum(qk, axis=-1) + inter_w * jnp.einsum('bhctd,bhcd->bhct', q, n_prev)
    h = num / jnp.maximum(jnp.abs(den), jnp.exp(-m_t))[..., None]
    return h.reshape(B, H, S, D)


def mlstm_mixer(mq, mk, mv, mo, mg, mlstm_conv, mlstm_gate_b, mlstm_head_norm):
    B, S, _ = mq.shape
    qk = lax.conv_general_dilated(jnp.concatenate([mq, mk], axis=-1), mlstm_conv[:, None, :],
                                  window_strides=(1,), padding='SAME',
                                  dimension_numbers=('NWC', 'WIO', 'NWC'),
                                  feature_group_count=2 * MLSTM_WIDTH)
    qc, kc = jnp.split(jax.nn.silu(qk), 2, axis=-1)

    def heads(t):
        return t.astype(jnp.float32).reshape(B, S, MLSTM_HEADS, MLSTM_HEAD_DIM).transpose(0, 2, 1, 3)

    q, k, v = heads(qc), heads(kc) * (MLSTM_HEAD_DIM ** -0.5), heads(mv)
    pre = (mg.astype(jnp.float32) + mlstm_gate_b.astype(jnp.float32)).reshape(B, S, 4, MLSTM_HEADS).transpose(2, 0, 3, 1)
    i_fw, f_fw, i_bw, f_bw = pre[0], pre[1], pre[2], pre[3]

    def rev(t):
        return jnp.flip(t, axis=2)

    h_fw = mlstm_chunkwise(q, k, v, i_fw, jax.nn.log_sigmoid(f_fw))
    h_bw = rev(mlstm_chunkwise(rev(q), rev(k), rev(v), rev(i_bw), rev(jax.nn.log_sigmoid(f_bw))))
    h = (h_fw + h_bw).transpose(0, 2, 1, 3)
    mu = jnp.mean(h, axis=-1, keepdims=True)
    var = jnp.mean(jnp.square(h - mu), axis=-1, keepdims=True)
    hn = ((h - mu) * lax.rsqrt(var + LN_EPS)).reshape(B, S, MLSTM_WIDTH) * mlstm_head_norm.astype(jnp.float32)
    return (jax.nn.sigmoid(mo.astype(jnp.float32)) * hn).astype(mq.dtype)


def token_mixer(u, cos, sin, w_in, gqa_q_norm, gqa_k_norm, mla_q_norm, mla_w_uq, mla_kv_norm, mla_w_ukv,
                mlstm_conv, mlstm_gate_b, mlstm_head_norm, w_out):
    B, S, _ = u.shape
    gq, gk, gv, cq, ckv, kr, mq, mk, mv, mo, mg = jnp.split(u @ w_in, IN_SPLITS, axis=-1)

    q = apply_rope(rms_norm(gq.reshape(B, S, GQA_HEADS, GQA_HEAD_DIM), gqa_q_norm), cos, sin)
    k = apply_rope(rms_norm(gk.reshape(B, S, GQA_KV_HEADS, GQA_HEAD_DIM), gqa_k_norm), cos, sin)
    v = gv.reshape(B, S, GQA_KV_HEADS, GQA_HEAD_DIM)
    q = q.reshape(B, S, GQA_KV_HEADS, GQA_HEADS // GQA_KV_HEADS, GQA_HEAD_DIM)
    out_a = blocked_attention(q, k, v)

    qm = (rms_norm(cq, mla_q_norm) @ mla_w_uq).reshape(B, S, MLA_HEADS, MLA_NOPE_DIM + MLA_ROPE_DIM)
    q_nope, q_rope = jnp.split(qm, [MLA_NOPE_DIM], axis=-1)
    kvm = (rms_norm(ckv, mla_kv_norm) @ mla_w_ukv).reshape(B, S, MLA_HEADS, MLA_NOPE_DIM + MLA_V_DIM)
    k_nope, v_m = jnp.split(kvm, [MLA_NOPE_DIM], axis=-1)
    k_rope = apply_rope(kr.reshape(B, S, 1, MLA_ROPE_DIM), cos, sin)
    q_m = jnp.concatenate([q_nope, apply_rope(q_rope, cos, sin)], axis=-1)[:, :, :, None, :]
    k_m = jnp.concatenate([k_nope, jnp.broadcast_to(k_rope, (B, S, MLA_HEADS, MLA_ROPE_DIM))], axis=-1)
    out_b = blocked_attention(q_m, k_m, v_m)

    out_c = mlstm_mixer(mq, mk, mv, mo, mg, mlstm_conv, mlstm_gate_b, mlstm_head_norm)

    return jnp.concatenate([out_a, out_b, out_c], axis=-1) @ w_out


def dense_swiglu(u, w_gate, w_up, w_down):
    return (jax.nn.silu(u @ w_gate) * (u @ w_up)) @ w_down


def moe_swiglu(u, router_w, w_gate, w_up, w_down):
    logits = (u @ router_w).astype(jnp.float32)
    top_v, top_i = lax.top_k(logits, TOP_K)
    top_w = jax.nn.softmax(top_v, axis=-1)
    gates = jnp.sum(jax.nn.one_hot(top_i, N_EXPERTS, dtype=jnp.float32) * top_w[..., None], axis=-2).astype(u.dtype)
    y = jnp.zeros_like(u)
    for e in range(N_EXPERTS):
        h = jax.nn.silu(u @ w_gate[e]) * (u @ w_up[e])
        y = y + gates[..., e:e + 1] * (h @ w_down[e])
    return y


def setup_inputs(seed: int = 0) -> dict:
    key = jax.random.key(seed)
    keys = iter(jax.random.split(key, 128))

    def nrm(shape, std):
        return jax.random.normal(next(keys), shape, jnp.float32) * std

    def gain(n):
        return 1.0 + nrm((n,), 0.02)

    inp = {'x': nrm((BATCH, SEQ, D_MODEL), 1.0), 'c': nrm((BATCH, D_MODEL), 1.0)}
    f_bias = jnp.linspace(3.0, 6.0, MLSTM_HEADS, dtype=jnp.float32)
    for i in range(DEPTH):
        p = 'l%d_' % i
        inp[p + 'ada_w'] = nrm((D_MODEL, 6 * D_MODEL), 0.5 * D_MODEL ** -0.5)
        inp[p + 'ada_b'] = nrm((6 * D_MODEL,), 0.02)
        inp[p + 'w_in'] = nrm((D_MODEL, D_IN), D_MODEL ** -0.5)
        inp[p + 'gqa_q_norm'] = gain(GQA_HEAD_DIM)
        inp[p + 'gqa_k_norm'] = gain(GQA_HEAD_DIM)
        inp[p + 'mla_q_norm'] = gain(MLA_Q_RANK)
        inp[p + 'mla_w_uq'] = nrm((MLA_Q_RANK, MLA_HEADS * (MLA_NOPE_DIM + MLA_ROPE_DIM)), MLA_Q_RANK ** -0.5)
        inp[p + 'mla_kv_norm'] = gain(MLA_KV_RANK)
        inp[p + 'mla_w_ukv'] = nrm((MLA_KV_RANK, MLA_HEADS * (MLA_NOPE_DIM + MLA_V_DIM)), MLA_KV_RANK ** -0.5)
        inp[p + 'mlstm_conv'] = nrm((CONV_W, 2 * MLSTM_WIDTH), CONV_W ** -0.5)
        inp[p + 'mlstm_gate_b'] = jnp.concatenate([
            nrm((MLSTM_HEADS,), 0.1), f_bias + nrm((MLSTM_HEADS,), 0.1),
            nrm((MLSTM_HEADS,), 0.1), f_bias + nrm((MLSTM_HEADS,), 0.1)])
        inp[p + 'mlstm_head_norm'] = gain(MLSTM_WIDTH)
        inp[p + 'w_out'] = nrm((MIX_OUT, D_MODEL), DEEPNORM_BETA * MIX_OUT ** -0.5)
        inp[p + 'ln1_g'] = gain(D_MODEL)
        inp[p + 'ln1_b'] = nrm((D_MODEL,), 0.02)
        if i % 2 == 0:
            inp[p + 'ffn_w_gate'] = nrm((D_MODEL, DENSE_FF), D_MODEL ** -0.5)
            inp[p + 'ffn_w_up'] = nrm((D_MODEL, DENSE_FF), D_MODEL ** -0.5)
            inp[p + 'ffn_w_down'] = nrm((DENSE_FF, D_MODEL), DEEPNORM_BETA * DENSE_FF ** -0.5)
        else:
            inp[p + 'router_w'] = nrm((D_MODEL, N_EXPERTS), D_MODEL ** -0.5)
            inp[p + 'moe_w_gate'] = nrm((N_EXPERTS, D_MODEL, EXPERT_FF), D_MODEL ** -0.5)
            inp[p + 'moe_w_up'] = nrm((N_EXPERTS, D_MODEL, EXPERT_FF), D_MODEL ** -0.5)
            inp[p + 'moe_w_down'] = nrm((N_EXPERTS, EXPERT_FF, D_MODEL), DEEPNORM_BETA * EXPERT_FF ** -0.5)
        inp[p + 'ln2_g'] = gain(D_MODEL)
        inp[p + 'ln2_b'] = nrm((D_MODEL,), 0.02)
    return inp


def reference(x, c,
              l0_ada_w, l0_ada_b, l0_w_in, l0_gqa_q_norm, l0_gqa_k_norm, l0_mla_q_norm, l0_mla_w_uq,
              l0_mla_kv_norm, l0_mla_w_ukv, l0_mlstm_conv, l0_mlstm_gate_b, l0_mlstm_head_norm, l0_w_out,
              l0_ln1_g, l0_ln1_b, l0_ffn_w_gate, l0_ffn_w_up, l0_ffn_w_down, l0_ln2_g, l0_ln2_b,
              l1_ada_w, l1_ada_b, l1_w_in, l1_gqa_q_norm, l1_gqa_k_norm, l1_mla_q_norm, l1_mla_w_uq,
              l1_mla_kv_norm, l1_mla_w_ukv, l1_mlstm_conv, l1_mlstm_gate_b, l1_mlstm_head_norm, l1_w_out,
              l1_ln1_g, l1_ln1_b, l1_router_w, l1_moe_w_gate, l1_moe_w_up, l1_moe_w_down, l1_ln2_g, l1_ln2_b):
    ada_params = ((l0_ada_w, l0_ada_b), (l1_ada_w, l1_ada_b))
    mixer_params = (
        (l0_w_in, l0_gqa_q_norm, l0_gqa_k_norm, l0_mla_q_norm, l0_mla_w_uq, l0_mla_kv_norm, l0_mla_w_ukv,
         l0_mlstm_conv, l0_mlstm_gate_b, l0_mlstm_head_norm, l0_w_out),
        (l1_w_in, l1_gqa_q_norm, l1_gqa_k_norm, l1_mla_q_norm, l1_mla_w_uq, l1_mla_kv_norm, l1_mla_w_ukv,
         l1_mlstm_conv, l1_mlstm_gate_b, l1_mlstm_head_norm, l1_w_out))
    ffn_params = ((l0_ffn_w_gate, l0_ffn_w_up, l0_ffn_w_down),
                  (l1_router_w, l1_moe_w_gate, l1_moe_w_up, l1_moe_w_down))
    norm_params = ((l0_ln1_g, l0_ln1_b, l0_ln2_g, l0_ln2_b), (l1_ln1_g, l1_ln1_b, l1_ln2_g, l1_ln2_b))

    cos, sin = axial_rope(x.shape[1], GQA_HEAD_DIM)
    c_act = jax.nn.silu(c)
    for i in range(DEPTH):
        ada_w, ada_b = ada_params[i]
        ln1_g, ln1_b, ln2_g, ln2_b = norm_params[i]
        mod = (c_act @ ada_w + ada_b)[:, None, :]
        shift1, scale1, gate1, shift2, scale2, gate2 = jnp.split(mod, 6, axis=-1)
        u = x * (1.0 + scale1) + shift1
        x = layer_norm(DEEPNORM_ALPHA * x + gate1 * token_mixer(u, cos, sin, *mixer_params[i]), ln1_g, ln1_b)
        u = x * (1.0 + scale2) + shift2
        if i % 2 == 0:
            f = dense_swiglu(u, *ffn_params[i])
        else:
            f = moe_swiglu(u, *ffn_params[i])
        x = layer_norm(DEEPNORM_ALPHA * x + gate2 * f, ln2_g, ln2_b)
    return x
```

```cpp
#include <hip/hip_runtime.h>
#include <cstdio>
#include <cstdint>
#include <cmath>

#define LAS __attribute__((address_space(3)))
#define GAS __attribute__((address_space(1)))
typedef unsigned short bf16;
typedef unsigned v4u __attribute__((ext_vector_type(4)));
typedef unsigned v2u __attribute__((ext_vector_type(2)));
typedef float f32x4 __attribute__((ext_vector_type(4)));

constexpr int S = 8192, D = 2048, DIN = 4432, DINP = 4608;
constexpr int NMOD = 6 * D;
constexpr int FF0 = 5632, FF1 = 7168, NEXP = 8;
constexpr int MPAD = 18432;
constexpr int NCH = 64, CH = 128, MH = 4, MD = 128;
constexpr float ALPHA = 1.4142135623730951f;
constexpr int NWAVES = 8, NTHR = 512;
constexpr float MLA_QSCALE = 0.07216878364870323f * 1.4426950408889634f;
constexpr float GQA_QSCALE = 0.125f * 1.4426950408889634f;

constexpr int C_GQ = 0, C_GK = 1024, C_GV = 1280, C_CQ = 1536, C_CKV = 2048, C_KR = 2304, C_MQ = 2368, C_MK = 2880, C_MV = 3392, C_MO = 3904, C_MG = 4416;

constexpr size_t MiB = 1u << 20;
constexpr size_t O_CTL = 0;
constexpr size_t O_MOD = O_CTL + MiB;
constexpr size_t O_GI = O_MOD + MiB;
constexpr size_t O_LF = O_GI + MiB;
constexpr size_t O_GATES = O_LF;
constexpr size_t O_BC = O_LF + MiB;
constexpr size_t O_WW = O_BC + MiB;
constexpr size_t O_PM = O_WW + MiB;
constexpr size_t O_KS = O_PM + MiB;
constexpr size_t O_CHS = O_KS + MiB;
constexpr size_t O_BCNT = O_CHS + 256 * 1024;
constexpr size_t O_MLAB = O_CHS + 512 * 1024;
constexpr size_t O_TOPK = O_CHS + MiB;
constexpr size_t O_U = O_TOPK + MiB;
constexpr size_t O_XA = O_U + 32 * MiB;
constexpr size_t O_XB = O_XA + 64 * MiB;
constexpr size_t O_MIX = O_XB + 64 * MiB;
constexpr size_t O_QG = O_MIX + 32 * MiB;
constexpr size_t O_KG = O_QG + 16 * MiB;
constexpr size_t O_VG = O_KG + 4 * MiB;
constexpr size_t O_CQ = O_VG + 4 * MiB;
constexpr size_t O_CKV = O_CQ + 8 * MiB;
constexpr size_t O_QM = O_CKV + 4 * MiB;
constexpr size_t O_KM = O_QM + 12 * MiB;
constexpr size_t O_VM = O_KM + 12 * MiB;
constexpr size_t O_MQ = O_VM + 8 * MiB;
constexpr size_t O_MK = O_MQ + 8 * MiB;
constexpr size_t O_MV = O_MK + 8 * MiB;
constexpr size_t O_RAWQ = O_MV + 8 * MiB;
constexpr size_t O_RAWKV = O_RAWQ + 24 * MiB;
constexpr size_t O_KV = O_RAWKV + 32 * MiB;
constexpr size_t O_RAW = O_KV + 32 * MiB;
constexpr size_t O_H = O_RAW + 144 * MiB;
constexpr size_t O_XS = O_H + 252 * MiB;
constexpr size_t O_WIN = O_XS + 72 * MiB;
constexpr size_t O_WUQ = O_WIN + 36 * MiB;
constexpr size_t O_WUKV = O_WUQ + 2 * MiB;
constexpr size_t O_WOUT = O_WUKV + 2 * MiB;
constexpr size_t O_WGU0 = O_WOUT + 16 * MiB;
constexpr size_t O_WD0 = O_WGU0 + 44 * MiB;
constexpr size_t O_WGU1 = O_WD0 + 22 * MiB;
constexpr size_t O_WD1 = O_WGU1 + 448 * MiB;
constexpr size_t O_ROPE = O_WD1 + 224 * MiB;
constexpr size_t O_END = O_ROPE + 2 * MiB;
constexpr int CW_CNT = 64;
constexpr int CW_BAR = 4096;

__device__ __forceinline__ float bf2f(bf16 v) { return __uint_as_float((unsigned)v << 16); }
__device__ __forceinline__ bf16 f2bf(float f) { unsigned u = __float_as_uint(f); return (bf16)((u + 0x7fffu + ((u >> 16) & 1u)) >> 16); }
__device__ __forceinline__ float wave_sum(float v) {
#pragma unroll
    for (int o = 1; o < 64; o <<= 1) v += __shfl_xor(v, o);
    return v;
}
__device__ __forceinline__ float wave_max(float v) {
#pragma unroll
    for (int o = 1; o < 64; o <<= 1) v = fmaxf(v, __shfl_xor(v, o));
    return v;
}
__device__ __forceinline__ float siluf(float v) { return v / (1.f + expf(-v)); }
__device__ __forceinline__ float sigmoidf(float v) { return 1.f / (1.f + expf(-v)); }
__device__ __forceinline__ float logsigmoidf(float x) { return x >= 0.f ? -log1pf(expf(-x)) : x - log1pf(expf(x)); }
__device__ __forceinline__ int physt(int dir, int tl) { return dir ? (S - 1 - tl) : tl; }
__device__ __forceinline__ int opq_tid() { int t = threadIdx.x; asm volatile("" : "+v"(t)); return t; }

struct Args { const float* in[43]; float* out; unsigned char* ws; int ph_lo, ph_hi; };
#define LIN(k) (l ? a.in[22 + (k)] : a.in[2 + (k)])

struct Frame {
    LAS unsigned char* lds;
    unsigned char* ws;
    int tid, lane, wave, bid, nblk;
    int gw, ngw;
};

struct Seg { int start[9]; };
__device__ __forceinline__ Seg load_seg(const unsigned* cnt) {
    Seg s; int acc = 0;
#pragma unroll
    for (int e = 0; e < 8; ++e) { s.start[e] = acc; acc += (__builtin_amdgcn_readfirstlane((int)cnt[e]) + 255) & ~255; }
    s.start[8] = acc; return s;
}
__device__ __forceinline__ int seg_expert(const Seg& s, int row) {
    int e = -1;
#pragma unroll
    for (int i = 0; i < 8; ++i) if (row >= s.start[i] && row < s.start[i + 1]) e = i;
    return e;
}
#define XB_TMO      128
#define XB_XCNT(j)  (256  + 64 * (j))
#define XB_XSUB(j)  (1280 + 64 * (j))
#define XB_XGEN(j)  (2304 + 64 * (j))
#define XB_TOP      3328
#define XB_TOPGEN   3392
#define XCD_BAR_WORDS 3456
#define XB_SPIN_CAP (1u << 18)

__device__ __forceinline__ unsigned xb_ld(unsigned* p)              { return __hip_atomic_load(p, __ATOMIC_RELAXED, __HIP_MEMORY_SCOPE_AGENT); }
__device__ __forceinline__ unsigned xb_add(unsigned* p, unsigned v) { return __hip_atomic_fetch_add(p, v, __ATOMIC_RELAXED, __HIP_MEMORY_SCOPE_AGENT); }
__device__ __forceinline__ unsigned xb_xcc_id() { return (unsigned)__builtin_amdgcn_s_getreg((3 << 11) | 20) & 0xFu; }
#define XB_SPIN(cond, bar) do { unsigned _sp = 0; while (cond) { __builtin_amdgcn_s_sleep(1); \
    if ((++_sp & 255u) == 0u) { if (xb_ld(&(bar)[XB_TMO])) break; if (_sp > XB_SPIN_CAP) { atomicAdd(&(bar)[XB_TMO], 1u); break; } } } } while (0)

struct XcdBarrier {
    unsigned* bar; unsigned x;
    volatile LAS unsigned* st;
};

__device__ __forceinline__ XcdBarrier xcd_barrier_post(unsigned* bar, volatile LAS unsigned* st) {
    XcdBarrier b; b.bar = bar; b.x = xb_xcc_id(); b.st = st;
    if (threadIdx.x == 0) (void)xb_add(&bar[XB_XCNT(b.x)], 1u);
    return b;
}
__device__ __forceinline__ void xcd_barrier_complete(unsigned* bar, unsigned x, unsigned& nloc, unsigned& nx) {
    const unsigned G = gridDim.x * gridDim.y * gridDim.z;
    unsigned sum, cnt, mine, sp = 0u;
    for (;;) {
        sum = 0u; cnt = 0u; mine = 0u;
#pragma unroll
        for (unsigned j = 0; j < 16; ++j) { const unsigned c = xb_ld(&bar[XB_XCNT(j)]); sum += c; cnt += (c > 0u) ? 1u : 0u; mine = (j == x) ? c : mine; }
        if (sum == G) break;
        __builtin_amdgcn_s_sleep(1);
        if ((++sp & 255u) == 0u) { if (xb_ld(&bar[XB_TMO])) break; if (sp > XB_SPIN_CAP) { atomicAdd(&bar[XB_TMO], 1u); break; } }
    }
    nloc = mine > 0u ? mine : 1u; nx = cnt > 0u ? cnt : 1u;
}

__device__ __forceinline__ void xcd_barrier(const XcdBarrier& b) {
    asm volatile("s_waitcnt vmcnt(0)" ::: "memory");
    __syncthreads();
    if (threadIdx.x == 0) {
        unsigned* bar = b.bar;
        __builtin_amdgcn_s_waitcnt(0);
        unsigned nloc = b.st[0], nx = b.st[1];
        if (nloc == 0u) { xcd_barrier_complete(bar, b.x, nloc, nx); b.st[0] = nloc; b.st[1] = nx; }
        const unsigned old = xb_add(&bar[XB_XSUB(b.x)], 1u);
        const unsigned gen = old / nloc;
        if (old + 1u == (gen + 1u) * nloc) {
            __builtin_amdgcn_fence(__ATOMIC_RELEASE, "agent");
            asm volatile("s_waitcnt vmcnt(0)" ::: "memory");
            const unsigned og = xb_add(&bar[XB_TOP], 1u);
            const unsigned tg = og / nx;
            if (og + 1u == (tg + 1u) * nx) xb_add(&bar[XB_TOPGEN], 1u);
            else XB_SPIN(xb_ld(&bar[XB_TOPGEN]) == tg, bar);
            __builtin_amdgcn_fence(__ATOMIC_ACQUIRE, "agent");
            xb_add(&bar[XB_XGEN(b.x)], 1u);
            asm volatile("s_waitcnt vmcnt(0)" ::: "memory");
        } else {
            XB_SPIN(xb_ld(&bar[XB_XGEN(b.x)]) == gen, bar);
            __builtin_amdgcn_fence(__ATOMIC_ACQUIRE, "agent");
            asm volatile("s_waitcnt vmcnt(0)" ::: "memory");
        }
    }
    __syncthreads();
}

namespace pg8 {
#define PG8_LAS __attribute__((address_space(3)))
typedef unsigned short bf16_t;
typedef short bf16x8 __attribute__((ext_vector_type(8)));
typedef float f32x4 __attribute__((ext_vector_type(4)));
typedef unsigned u32x4 __attribute__((ext_vector_type(4)));
constexpr int BM = 256, BK = 64, HALF = 128, HTB = HALF * BK * 2  , STAGE_BYTES = 8 * HTB, NXCD = 8, WGM = 8;

__host__ __device__ __forceinline__ int lds_byte(int r, int c) { const int st = (r >> 4) * 2 + (c >> 5), rr = r & 15, cc = c & 31, ob = rr * 64 + cc * 2; return st * 1024 + (ob ^ (((ob >> 9) & 1) << 5)); }
__host__ __device__ __forceinline__ void stage_rc(int b, int& R, int& C) { const int st = b / 1024, sb = b % 1024, swz = sb ^ (((sb >> 9) & 1) << 5); R = (st >> 1) * 16 + swz / 64; C = (st & 1) * 32 + (swz % 64) / 2; }
__host__ __device__ __forceinline__ int perm32(int rho) { const int n = rho >> 4, i = rho & 15; return 8 * (i >> 2) + 4 * n + (i & 3); }

struct Unit { int pm, pn, e, ks; };
struct Gemm { const bf16_t* A; const bf16_t* Bt; int M, N, K; size_t gbytes; int ldk; };

struct StaticOrder {
    int nM, nN, nwg, G, c;
    __host__ __device__ void init(int M, int N, int G_, int c_) { nM = M / BM; nN = N / BM; nwg = nM * nN; G = G_; c = c_; }
    __host__ __device__ bool next(int i, Unit& u) const {
        const long L = (long)i * G + c; if (L >= nwg) return false;
        int wgid = (int)L; { const int q = nwg / NXCD, r = nwg % NXCD, xcd = wgid % NXCD, off = wgid / NXCD; wgid = (xcd < r ? xcd * (q + 1) : r * (q + 1) + (xcd - r) * q) + off; }
        const int nig = WGM * nN, gid = wgid / nig, fm = gid * WGM, gsz = (nM - fm) < WGM ? (nM - fm) : WGM;
        u.pm = fm + ((wgid % nig) % gsz); u.pn = (wgid % nig) / gsz; u.e = 0; u.ks = 0; return true;
    }
    __device__ __forceinline__ void a_ready(const Unit&) const {}
    __device__ __forceinline__ void done(const Unit&) const {}
};


struct GroupedOrder {
    int nN, G, c; int tstart[9];
    __device__ __forceinline__ bool next(int i, Unit& u) const {
        int L = i * G + c; if (L >= tstart[8] * nN) return false;
        int es = -1, ts = 0, te = 1;
#pragma unroll
        for (int e = 0; e < 8; ++e) { const int t = tstart[e + 1] - tstart[e], ue = t * nN; if (es < 0) { if (L < ue) { es = e; ts = tstart[e]; te = t; } else L -= ue; } }
        u.e = es; u.pm = ts + L / nN; u.pn = L % nN; u.ks = 0; return true;
    }
    __device__ __forceinline__ void a_ready(const Unit&) const {}
    __device__ __forceinline__ void done(const Unit&) const {}
};
struct DownPlan { int T, tfull, tt, f; };
__device__ __forceinline__ DownPlan down_plan(const int (&tstart)[9], int G) {
    DownPlan p; p.T = tstart[8]; const int U = p.T * 8, R = U / G; int r = U - R * G;
    p.f = 1; if (r > 0 && (G % 8) == 0) { if (r * 8 <= G) p.f = 8; else if (r * 4 <= G) p.f = 4; else if (r * 2 <= G) p.f = 2; }
    if (p.f == 1) { p.tfull = p.T; p.tt = 0; } else { p.tfull = R * (G / 8); p.tt = p.T - p.tfull; }
    return p;
}
struct DownOrder {
    int G, c; bool tail; DownPlan p; int tstart[9];
    __device__ __forceinline__ bool next(int i, Unit& u) const {
        const int L = i * G + c;
        if (!tail) { if (L >= p.tfull * 8) return false; u.pm = L >> 3; u.pn = L & 7; u.ks = 0; }
        else { if (L >= p.tt * 8 * p.f) return false; u.ks = L % p.f; const int q = L / p.f; u.pn = q & 7; u.pm = p.tfull + (q >> 3); }
        int es = 0;
#pragma unroll
        for (int e = 1; e < 8; ++e) if (u.pm >= tstart[e]) es = e;
        u.e = es; return true;
    }
    __device__ __forceinline__ void a_ready(const Unit&) const {}
    __device__ __forceinline__ void done(const Unit&) const {}
};
__device__ __forceinline__ unsigned cvt_pk_bf16(float lo, float hi) { unsigned r; asm volatile("v_cvt_pk_bf16_f32 %0, %1, %2" : "=v"(r) : "v"(lo), "v"(hi)); return r; }
struct EpiF32 {
    static constexpr bool PERM = false, AFTER_DRAIN = false;
    float* C; int ldc;
    __device__ __forceinline__ void operator()(const f32x4 (&acc)[2][2][4][2], const Unit& u, int wr, int wc, int fr, int fq) const {
        const int row0 = u.pm * BM + wr * 64 + fr, col0 = u.pn * BM + wc * 32 + 4 * fq;
#pragma unroll
        for (int ai = 0; ai < 2; ++ai)
#pragma unroll
            for (int m = 0; m < 4; ++m) { float* rowp = C + (size_t)(row0 + ai * HALF + m * 16) * ldc + col0;
#pragma unroll
                for (int bj = 0; bj < 2; ++bj)
#pragma unroll
                    for (int n = 0; n < 2; ++n) *(f32x4*)(rowp + bj * HALF + n * 16) = acc[ai][bj][m][n]; }
    }
};
struct EpiBf16 {
    static constexpr bool PERM = true, AFTER_DRAIN = false;
    bf16_t* O; int ldc;
    __device__ __forceinline__ void operator()(const f32x4 (&acc)[2][2][4][2], const Unit& u, int wr, int wc, int fr, int fq) const {
        const int row0 = u.pm * BM + wr * 64 + fr, col0 = u.pn * BM + wc * 32 + 8 * fq;
#pragma unroll
        for (int ai = 0; ai < 2; ++ai)
#pragma unroll
            for (int m = 0; m < 4; ++m) { bf16_t* rowp = O + (size_t)(row0 + ai * HALF + m * 16) * ldc + col0;
#pragma unroll
                for (int bj = 0; bj < 2; ++bj) { const f32x4 v0 = acc[ai][bj][m][0], v1 = acc[ai][bj][m][1];
                    u32x4 w; w.x = cvt_pk_bf16(v0[0], v0[1]); w.y = cvt_pk_bf16(v0[2], v0[3]); w.z = cvt_pk_bf16(v1[0], v1[1]); w.w = cvt_pk_bf16(v1[2], v1[3]);
                    *(u32x4*)(rowp + bj * HALF) = w; } }
    }
};
struct EpiBf16Gate {
    static constexpr bool PERM = true, AFTER_DRAIN = false;
    bf16_t* O; int ldc; float* G; int gc0;
    __device__ __forceinline__ void operator()(const f32x4 (&acc)[2][2][4][2], const Unit& u, int wr, int wc, int fr, int fq) const {
        EpiBf16{O, ldc}(acc, u, wr, wc, fr, fq);
        const int c0 = u.pn * BM + wc * 32 + 8 * fq - gc0;
        if (c0 >= 0 && c0 < 16) { const int row0 = u.pm * BM + wr * 64 + fr;
#pragma unroll
            for (int ai = 0; ai < 2; ++ai)
#pragma unroll
                for (int m = 0; m < 4; ++m) { float* gp = G + (size_t)(row0 + ai * HALF + m * 16) * 16 + c0; *(f32x4*)gp = acc[ai][0][m][0]; *(f32x4*)(gp + 4) = acc[ai][0][m][1]; } }
    }
};
struct EpiF32Part {
    static constexpr bool PERM = false, AFTER_DRAIN = false;
    float* P; int ldc, tfull, f;
    __device__ __forceinline__ void operator()(const f32x4 (&acc)[2][2][4][2], const Unit& u, int wr, int wc, int fr, int fq) const {
        const int row0 = ((u.pm - tfull) * f + u.ks) * BM + wr * 64 + fr, col0 = u.pn * BM + wc * 32 + 4 * fq;
#pragma unroll
        for (int ai = 0; ai < 2; ++ai)
#pragma unroll
            for (int m = 0; m < 4; ++m) { float* rowp = P + (size_t)(row0 + ai * HALF + m * 16) * ldc + col0;
#pragma unroll
                for (int bj = 0; bj < 2; ++bj)
#pragma unroll
                    for (int n = 0; n < 2; ++n) *(f32x4*)(rowp + bj * HALF + n * 16) = acc[ai][bj][m][n]; }
    }
};
struct EpiBf16Part {
    static constexpr bool PERM = true, AFTER_DRAIN = false;
    bf16_t* P; int ldc, tfull, f;
    __device__ __forceinline__ void operator()(const f32x4 (&acc)[2][2][4][2], const Unit& u, int wr, int wc, int fr, int fq) const {
        const int row0 = ((u.pm - tfull) * f + u.ks) * BM + wr * 64 + fr, col0 = u.pn * BM + wc * 32 + 8 * fq;
#pragma unroll
        for (int ai = 0; ai < 2; ++ai)
#pragma unroll
            for (int m = 0; m < 4; ++m) { bf16_t* rowp = P + (size_t)(row0 + ai * HALF + m * 16) * ldc + col0;
#pragma unroll
                for (int bj = 0; bj < 2; ++bj) { const f32x4 v0 = acc[ai][bj][m][0], v1 = acc[ai][bj][m][1];
                    u32x4 w; w.x = cvt_pk_bf16(v0[0], v0[1]); w.y = cvt_pk_bf16(v0[2], v0[3]); w.z = cvt_pk_bf16(v1[0], v1[1]); w.w = cvt_pk_bf16(v1[2], v1[3]);
                    *(u32x4*)(rowp + bj * HALF) = w; } }
    }
};
__device__ __forceinline__ float silu_fast(float v) { return v * __builtin_amdgcn_rcpf(1.f + __builtin_amdgcn_exp2f(-1.4426950408889634f * v)); }
struct EpiSwiglu {
    static constexpr bool PERM = true, AFTER_DRAIN = false;
    bf16_t* O; int ldc;
    __device__ __forceinline__ void operator()(const f32x4 (&acc)[2][2][4][2], const Unit& u, int wr, int wc, int fr, int fq) const {
        const int row0 = u.pm * BM + wr * 64 + fr, col0 = u.pn * HALF + wc * 32 + 8 * fq;
#pragma unroll
        for (int ai = 0; ai < 2; ++ai)
#pragma unroll
            for (int m = 0; m < 4; ++m) { bf16_t* rowp = O + (size_t)(row0 + ai * HALF + m * 16) * ldc + col0;
                const f32x4 g0 = acc[ai][0][m][0], g1 = acc[ai][0][m][1], u0 = acc[ai][1][m][0], u1 = acc[ai][1][m][1];
                u32x4 w; w.x = cvt_pk_bf16(silu_fast(g0[0]) * u0[0], silu_fast(g0[1]) * u0[1]); w.y = cvt_pk_bf16(silu_fast(g0[2]) * u0[2], silu_fast(g0[3]) * u0[3]);
                w.z = cvt_pk_bf16(silu_fast(g1[0]) * u1[0], silu_fast(g1[1]) * u1[1]); w.w = cvt_pk_bf16(silu_fast(g1[2]) * u1[2], silu_fast(g1[3]) * u1[3]);
                *(u32x4*)rowp = w; }
    }
};

template <class Epi, class Sched, bool ALIGN_EPI = false, bool SP2 = false>
__device__ __forceinline__ void gemm_phase(PG8_LAS unsigned char* lds, const Gemm g, const Sched& S, const Epi& E) {
    const int tid = opq_tid(), wid = __builtin_amdgcn_readfirstlane(tid >> 6), lane = tid & 63, wr = wid >> 2, wc = wid & 3, fr = lane & 15, fq = lane >> 4;
    const int K = g.K, nt = K / BK, LD = g.ldk;
    unsigned voffA[2], voffB[2];
#pragma unroll
    for (int i = 0; i < 2; ++i) { int R, C; stage_rc(tid * 16 + i * 8192, R, C); const int Rb = Epi::PERM ? ((R & ~31) + perm32(R & 31)) : R;
        voffA[i] = (unsigned)(R * LD + C) * 2u; voffB[i] = (unsigned)(Rb * LD + C) * 2u; }
    const size_t kstep = (size_t)(BK * 2);
    const size_t hstep = (size_t)HALF * LD * 2;
    const size_t tstep = 2 * hstep;
    const unsigned ldsw = (unsigned)wid * 1024u;
    const int aoff = lds_byte(wr * 64 + fr, fq * 8), boff = lds_byte(wc * 32 + fr, fq * 8);
#define PG8_SA(b, h) (((b) * 2 + (h)) * HTB)
#define PG8_SB(b, h) ((4 + (b) * 2 + (h)) * HTB)
#define PG8_STAGE(bufoff, gbase, voff) do { _Pragma("unroll") for (int _i = 0; _i < 2; ++_i) \
        __builtin_amdgcn_global_load_lds((const unsigned*)((const char*)(gbase) + (voff)[_i]), (PG8_LAS unsigned*)(lds + (bufoff) + ldsw + _i * 8192), 16, 0, 0); } while (0)
#define PG8_LDA(dst, b, h) do { _Pragma("unroll") for (int m = 0; m < 4; ++m) _Pragma("unroll") for (int k = 0; k < 2; ++k) dst[m][k] = *(const PG8_LAS bf16x8*)(lds + PG8_SA(b, h) + aoff + m * 2048 + k * 1024); } while (0)
#define PG8_LDB(dst, b, h) do { _Pragma("unroll") for (int n = 0; n < 2; ++n) _Pragma("unroll") for (int k = 0; k < 2; ++k) dst[n][k] = *(const PG8_LAS bf16x8*)(lds + PG8_SB(b, h) + boff + n * 2048 + k * 1024); } while (0)
#define PG8_MMA(ai, bj, At, Bt) do { __builtin_amdgcn_s_setprio(1); _Pragma("unroll") for (int m = 0; m < 4; ++m) _Pragma("unroll") for (int n = 0; n < 2; ++n) _Pragma("unroll") for (int k = 0; k < 2; ++k) \
        acc[ai][bj][m][n] = __builtin_amdgcn_mfma_f32_16x16x32_bf16(Bt[n][k], At[m][k], acc[ai][bj][m][n], 0, 0, 0); __builtin_amdgcn_s_setprio(0); } while (0)
#define PG8_WAIT_V(n) asm volatile("s_waitcnt vmcnt(" #n ")" ::: "memory")
#define PG8_WAIT_L(n) asm volatile("s_waitcnt lgkmcnt(" #n ")" ::: "memory")
#define PG8_BAR __builtin_amdgcn_s_barrier()
#define PG8_SCHED __builtin_amdgcn_sched_barrier(0)
    Unit cur, nxt; int ui = 0;
    if (!S.next(0, cur)) return;
    f32x4 acc[2][2][4][2];
#pragma unroll
    for (int a = 0; a < 2; ++a)
#pragma unroll
        for (int b = 0; b < 2; ++b)
#pragma unroll
            for (int m = 0; m < 4; ++m)
#pragma unroll
                for (int n = 0; n < 2; ++n) acc[a][b][m][n] = (f32x4){0.f, 0.f, 0.f, 0.f};
    bf16x8 At[4][2], B0[2][2], B1[2][2];
    const char* cA = (const char*)g.A + (size_t)cur.pm * tstep + (size_t)cur.ks * K * 2; const char* cB = (const char*)g.Bt + (size_t)cur.e * g.gbytes + (size_t)cur.pn * tstep + (size_t)cur.ks * K * 2;
    S.a_ready(cur);
    if constexpr (SP2) {
        PG8_STAGE(PG8_SB(0, 0), cB, voffB); PG8_STAGE(PG8_SB(0, 1), cB + hstep, voffB); PG8_STAGE(PG8_SA(0, 0), cA, voffA); PG8_STAGE(PG8_SA(0, 1), cA + hstep, voffA);
        if (wr == 1) PG8_BAR;
        PG8_WAIT_V(2); PG8_BAR;
        PG8_STAGE(PG8_SB(1, 0), cB + kstep, voffB); PG8_STAGE(PG8_SA(1, 0), cA + kstep, voffA); PG8_STAGE(PG8_SB(1, 1), cB + hstep + kstep, voffB);
        PG8_WAIT_V(6); PG8_BAR;
    } else {
        PG8_STAGE(PG8_SB(0, 0), cB, voffB); PG8_STAGE(PG8_SA(0, 0), cA, voffA); PG8_STAGE(PG8_SB(0, 1), cB + hstep, voffB); PG8_STAGE(PG8_SA(0, 1), cA + hstep, voffA);
        if (wr == 1) PG8_BAR;
        PG8_WAIT_V(4); PG8_BAR;
        PG8_STAGE(PG8_SB(1, 0), cB + kstep, voffB); PG8_STAGE(PG8_SA(1, 0), cA + kstep, voffA); PG8_STAGE(PG8_SB(1, 1), cB + hstep + kstep, voffB);
        PG8_WAIT_V(6); PG8_BAR;
    }
    for (;;) {
        const bool has_next = S.next(ui + 1, nxt);
        const char* nA = has_next ? (const char*)g.A + (size_t)nxt.pm * tstep + (size_t)nxt.ks * K * 2 : cA; const char* nB = has_next ? (const char*)g.Bt + (size_t)nxt.e * g.gbytes + (size_t)nxt.pn * tstep + (size_t)nxt.ks * K * 2 : cB;
        for (int t = 0; t < nt; t += 2) {
            const bool last = (t == nt - 2);
            const char* a1 = cA + (size_t)(t + 1) * kstep;
            const char* a2 = last ? nA : cA + (size_t)(t + 2) * kstep; const char* b2 = last ? nB : cB + (size_t)(t + 2) * kstep;
            const char* a3 = a2 + kstep; const char* b3 = b2 + kstep;
            if (last && has_next) S.a_ready(nxt);
            if constexpr (SP2) {
            PG8_LDB(B0, 0, 0); PG8_LDB(B1, 0, 1); PG8_SCHED; PG8_LDA(At, 0, 0); PG8_STAGE(PG8_SA(1, 1), a1 + hstep, voffA);
            PG8_WAIT_V(8); PG8_WAIT_L(0); PG8_BAR; PG8_MMA(0, 0, At, B0); PG8_MMA(0, 1, At, B1); PG8_BAR; PG8_SCHED;
            PG8_LDA(At, 0, 1); PG8_STAGE(PG8_SB(0, 0), b2, voffB); PG8_STAGE(PG8_SB(0, 1), b2 + hstep, voffB); PG8_STAGE(PG8_SA(0, 0), a2, voffA);
            PG8_WAIT_V(8); PG8_WAIT_L(0); PG8_BAR; PG8_MMA(1, 0, At, B0); PG8_MMA(1, 1, At, B1); PG8_BAR; PG8_SCHED;
            PG8_LDB(B0, 1, 0); PG8_LDB(B1, 1, 1); PG8_SCHED; PG8_LDA(At, 1, 0); PG8_STAGE(PG8_SA(0, 1), a2 + hstep, voffA);
            PG8_WAIT_V(8); PG8_WAIT_L(0); PG8_BAR; PG8_MMA(0, 0, At, B0); PG8_MMA(0, 1, At, B1); PG8_BAR; PG8_SCHED;
            PG8_LDA(At, 1, 1); PG8_STAGE(PG8_SB(1, 0), b3, voffB); PG8_STAGE(PG8_SB(1, 1), b3 + hstep, voffB); PG8_STAGE(PG8_SA(1, 0), a3, voffA);
            PG8_WAIT_V(8); PG8_WAIT_L(0); PG8_BAR; PG8_MMA(1, 0, At, B0); PG8_MMA(1, 1, At, B1); PG8_BAR; PG8_SCHED;
            } else {
            PG8_LDB(B0, 0, 0); PG8_SCHED; PG8_LDA(At, 0, 0); PG8_STAGE(PG8_SA(1, 1), a1 + hstep, voffA);
            PG8_WAIT_L(8); PG8_BAR; PG8_WAIT_L(0); PG8_MMA(0, 0, At, B0); PG8_BAR; PG8_SCHED;
            PG8_LDB(B1, 0, 1); PG8_STAGE(PG8_SB(0, 0), b2, voffB);
            PG8_BAR; PG8_WAIT_L(0); PG8_MMA(0, 1, At, B1); PG8_BAR;
            PG8_LDA(At, 0, 1); PG8_STAGE(PG8_SA(0, 0), a2, voffA);
            PG8_BAR; PG8_WAIT_L(0); PG8_MMA(1, 0, At, B0); PG8_BAR; PG8_SCHED;
            PG8_STAGE(PG8_SB(0, 1), b2 + hstep, voffB);
            PG8_WAIT_V(6); PG8_BAR; PG8_MMA(1, 1, At, B1); PG8_BAR;
            PG8_LDB(B0, 1, 0); PG8_SCHED; PG8_LDA(At, 1, 0); PG8_STAGE(PG8_SA(0, 1), a2 + hstep, voffA);
            PG8_WAIT_L(8); PG8_BAR; PG8_WAIT_L(0); PG8_MMA(0, 0, At, B0); PG8_BAR; PG8_SCHED;
            PG8_LDB(B1, 1, 1); PG8_STAGE(PG8_SB(1, 0), b3, voffB);
            PG8_BAR; PG8_WAIT_L(0); PG8_MMA(0, 1, At, B1); PG8_BAR;
            PG8_LDA(At, 1, 1); PG8_STAGE(PG8_SA(1, 0), a3, voffA);
            PG8_BAR; PG8_WAIT_L(0); PG8_MMA(1, 0, At, B0); PG8_BAR; PG8_SCHED;
            PG8_STAGE(PG8_SB(1, 1), b3 + hstep, voffB);
            PG8_WAIT_V(6); PG8_BAR; PG8_MMA(1, 1, At, B1); PG8_BAR;
            }
        }
        if constexpr (ALIGN_EPI) { if (wr == 0) PG8_BAR; }
        if constexpr (!Epi::AFTER_DRAIN) { E(acc, cur, wr, wc, fr, fq); S.done(cur); }
        if (!has_next) break;
#pragma unroll
        for (int a = 0; a < 2; ++a)
#pragma unroll
            for (int b = 0; b < 2; ++b)
#pragma unroll
                for (int m = 0; m < 4; ++m)
#pragma unroll
                    for (int n = 0; n < 2; ++n) acc[a][b][m][n] = (f32x4){0.f, 0.f, 0.f, 0.f};
        cur = nxt; cA = nA; cB = nB; ++ui;
        if constexpr (ALIGN_EPI) { if (wr == 1) PG8_BAR; }
    }
    PG8_WAIT_V(0);
    if constexpr (!ALIGN_EPI) { if (wr == 0) PG8_BAR; }
    PG8_BAR;
    if constexpr (Epi::AFTER_DRAIN) { E.fused(acc, cur, wr, wc, fr, fq, lds, wid, lane); S.done(cur); }
#undef PG8_SA
#undef PG8_SB
#undef PG8_STAGE
#undef PG8_LDA
#undef PG8_LDB
#undef PG8_MMA
#undef PG8_WAIT_V
#undef PG8_WAIT_L
#undef PG8_BAR
#undef PG8_SCHED
}
}

struct CvtJob { const GAS float* W; GAS bf16* WT; int K, N, nblk, map, item; };
__device__ __forceinline__ const float* cvt_opq(const float* p) { asm volatile("" : "+s"(p)); return p; }
__device__ __forceinline__ CvtJob cvt_decode(const Args& a, unsigned char* ws, int g) {
    const float* W; bf16* WT; int K, N, nblk, map = 0, item;
#define CVW(p) cvt_opq(p)
    if (g < 3856) {
        const int l = g >= 2984 ? 1 : 0;
        const int r = g < 872 ? g : (g < 2984 ? -1 : g - 2984);
        if (r >= 0) {
            if (r < 576) { W = CVW(LIN(2)); WT = (bf16*)(ws + O_WIN) + (size_t)l * DINP * D; K = D; N = DIN; nblk = DINP / 256; item = r; }
            else if (r < 600) { W = CVW(LIN(6)); WT = (bf16*)(ws + O_WUQ) + (size_t)l * 768 * 512; K = 512; N = 768; nblk = 3; item = r - 576; }
            else if (r < 616) { W = CVW(LIN(8)); WT = (bf16*)(ws + O_WUKV) + (size_t)l * 1024 * 256; K = 256; N = 1024; nblk = 4; item = r - 600; }
            else { W = CVW(LIN(12)); WT = (bf16*)(ws + O_WOUT) + (size_t)l * D * D; K = D; N = D; nblk = 8; item = r - 616; }
        } else { const int q = g - 872, m = q / 704; item = q % 704;
            if (m == 0) { W = CVW(a.in[17]); WT = (bf16*)(ws + O_WGU0); K = D; N = FF0; nblk = FF0 / 256; map = 1; }
            else if (m == 1) { W = CVW(a.in[18]); WT = (bf16*)(ws + O_WGU0); K = D; N = FF0; nblk = FF0 / 256; map = 2; }
            else { W = CVW(a.in[19]); WT = (bf16*)(ws + O_WD0); K = FF0; N = D; nblk = 8; }
        }
    } else { const int r = g - 3856, e = r / 2688, rr = r % 2688, m = rr / 896; item = rr % 896;
        if (m == 0) { W = CVW(a.in[38] + (size_t)e * D * FF1); WT = (bf16*)(ws + O_WGU1) + (size_t)e * 2 * FF1 * D; K = D; N = FF1; nblk = FF1 / 256; map = 1; }
        else if (m == 1) { W = CVW(a.in[39] + (size_t)e * D * FF1); WT = (bf16*)(ws + O_WGU1) + (size_t)e * 2 * FF1 * D; K = D; N = FF1; nblk = FF1 / 256; map = 2; }
        else { W = CVW(a.in[40] + (size_t)e * FF1 * D); WT = (bf16*)(ws + O_WD1) + (size_t)e * D * FF1; K = FF1; N = D; nblk = 8; }
    }
#undef CVW
    return CvtJob{(const GAS float*)W, (GAS bf16*)WT, K, N, nblk, map, item};
}
constexpr int CVT_ITEMS = 3856 + 8 * 2688, CVT_EARLY = 616;
constexpr int CVT_M0 = 28, CVT_M1 = 20, CVT_G0 = 21, CVT_G1 = 16, CVT_U0 = 28, CVT_U1 = 21;
constexpr int CVT_L1 = CVT_EARLY + 128 * CVT_M0 + 512 * CVT_G0;
static_assert(128 * CVT_M0 + 512 * CVT_G0 == 512 * CVT_U0 && CVT_L1 >= 3856 && CVT_L1 + 128 * CVT_M1 + 512 * CVT_G1 >= CVT_ITEMS && CVT_L1 + 512 * CVT_U1 >= CVT_ITEMS, "conversion shares");
__device__ __forceinline__ void cvt_load(const CvtJob& j, int c, int q, f32x4 (&v)[8]) {
    const int kb = j.item / j.nblk, nb = j.item % j.nblk, k0 = 64 * kb + 8 * (q >> 3), n = 256 * nb + 32 * c + 4 * (q & 7);
    if (n < j.N) {
#pragma unroll
        for (int i = 0; i < 8; ++i) v[i] = __builtin_nontemporal_load((const GAS f32x4*)(j.W + (size_t)(k0 + i) * j.N + n));
    } else {
#pragma unroll
        for (int i = 0; i < 8; ++i) v[i] = (f32x4){0.f, 0.f, 0.f, 0.f};
    }
}
__device__ __forceinline__ void cvt_store(const CvtJob& j, int c, int q, const f32x4 (&v)[8]) {
    const int kb = j.item / j.nblk, nb = j.item % j.nblk, k0 = 64 * kb + 8 * (q >> 3), n = 256 * nb + 32 * c + 4 * (q & 7);
    const int r0 = j.map == 0 ? n : (256 * (n >> 7) + (n & 127) + (j.map == 2 ? 128 : 0));
#pragma unroll
    for (int jj = 0; jj < 4; ++jj) {
        v4u o; o.x = pg8::cvt_pk_bf16(v[0][jj], v[1][jj]); o.y = pg8::cvt_pk_bf16(v[2][jj], v[3][jj]); o.z = pg8::cvt_pk_bf16(v[4][jj], v[5][jj]); o.w = pg8::cvt_pk_bf16(v[6][jj], v[7][jj]);
        *(GAS v4u*)(j.WT + (size_t)(r0 + jj) * j.K + k0) = o; }
}
__device__ __forceinline__ void ph_convert(const Frame& F, const Args& a, int g0, int g1) {
    const int c = F.wave, q = F.lane, st = F.nblk;
    f32x4 va[8], vb[8];
    int g = g0 + F.bid;
    if (g < g1) cvt_load(cvt_decode(a, F.ws, g), c, q, va);
    for (; g < g1; g += 2 * st) {
        const bool hb = g + st < g1;
        if (hb) cvt_load(cvt_decode(a, F.ws, g + st), c, q, vb);
        cvt_store(cvt_decode(a, F.ws, g), c, q, va);
        if (hb) { if (g + 2 * st < g1) cvt_load(cvt_decode(a, F.ws, g + 2 * st), c, q, va); cvt_store(cvt_decode(a, F.ws, g + st), c, q, vb); }
    }
}
__device__ __forceinline__ void ph_mod_fast(const Frame& F, const Args& a) {
    LAS float* ca = (LAS float*)F.lds; LAS float* part = ca + 2048;
    for (int k = F.tid; k < D; k += NTHR) ca[k] = siluf(a.in[1][k]);
    __syncthreads();
    float* mod = (float*)(F.ws + O_MOD);
    const int kk = F.tid >> 3, c4 = F.tid & 7;
    for (int strip = F.bid; strip < 768; strip += F.nblk) {
        const int l = strip / 384, j0 = (strip % 384) * 32;
        const float* W = (l ? a.in[22] : a.in[2]) + j0 + 4 * c4;
        f32x4 acc = {0.f, 0.f, 0.f, 0.f};
#pragma unroll 8
        for (int i = 0; i < 32; ++i) { const int k = kk + 64 * i; acc += __builtin_nontemporal_load((const f32x4*)(W + (size_t)k * NMOD)) * ca[k]; }
        *(LAS f32x4*)(part + kk * 32 + 4 * c4) = acc;
        __syncthreads();
        if (F.tid < 32) { float sacc = (l ? a.in[23] : a.in[3])[j0 + F.tid];
#pragma unroll 8
            for (int r = 0; r < 64; ++r) sacc += part[r * 32 + F.tid];
            mod[l * NMOD + j0 + F.tid] = sacc; }
        __syncthreads();
    }
}
template <class Epi>
__device__ __forceinline__ void fgemm(const Frame& F, const bf16* A, const bf16* Bt, int M, int N, int K, const Epi& E, int rot = 0) {
    int cid = F.bid + rot; if (cid >= F.nblk) cid -= F.nblk;
    pg8::Gemm g{A, Bt, M, N, K, 0, K}; pg8::StaticOrder So; So.init(M, N, F.nblk, cid);
    pg8::gemm_phase<Epi, pg8::StaticOrder, true, true>(F.lds, g, So, E);
}
template <class Epi>
__device__ __forceinline__ void fgemm_grouped(const Frame& F, const bf16* A, const bf16* Bt, int N, int K, size_t gbytes, const Seg& seg, const Epi& E) {
    pg8::Gemm g{A, Bt, MPAD, N, K, gbytes, K}; pg8::GroupedOrder So; So.nN = N / 256; So.G = F.nblk; So.c = F.bid;
#pragma unroll
    for (int i = 0; i < 9; ++i) So.tstart[i] = seg.start[i] >> 8;
    pg8::gemm_phase<Epi, pg8::GroupedOrder, true, true>(F.lds, g, So, E);
}

namespace fa {
using bf16x8 = __attribute__((ext_vector_type(8))) short;
using s16x4  = __attribute__((ext_vector_type(4))) short;
using f32x16 = __attribute__((ext_vector_type(16))) float;
using u32x4  = __attribute__((ext_vector_type(4))) unsigned;
constexpr int NW = 8, QBLK = 32, KVBLK = 64;
#define FA_SBAR() __builtin_amdgcn_sched_barrier(0)
__device__ __forceinline__ int crow(int r, int hi) { return (r & 3) + 8 * (r >> 2) + 4 * hi; }
__device__ __forceinline__ unsigned cvtpk(float lo, float hi) { unsigned r; asm volatile("v_cvt_pk_bf16_f32 %0, %1, %2" : "=v"(r) : "v"(lo), "v"(hi)); return r; }
template <int DQK> __device__ __forceinline__ int kswz(int row, int colB) { return row * (DQK * 2) + (colB ^ (((row >> 1) & 7) << 4)); }
template <int NB> __device__ __forceinline__ int v_st(int k, int c) { const int kk = (k & ~0xC) | ((k & 4) << 1) | ((k & 8) >> 1); return ((kk >> 3) * NB + (c >> 5)) * 512 + ((kk & 7) * 32 + (c & 31)) * 2; }
__device__ __forceinline__ int v_rd_base(int lane) { return ((lane & 3) << 3) | (((lane >> 2) & 3) << 6) | (((lane >> 4) & 1) << 5) | (((lane >> 5) & 1) << 8); }
template <int OFF> __device__ __forceinline__ s16x4 tr_read(int vb) { s16x4 r; asm volatile("ds_read_b64_tr_b16 %0, %1 offset:%2" : "=&v"(r) : "v"(vb), "i"(OFF) : "memory"); return r; }

__device__ __forceinline__ void partialSM(f32x16& p0, f32x16& p1, float& m_reg, float& mn, float& alpha, const float C, const float thr_raw) {
  float pmax = p0[0];
#pragma unroll
  for (int r = 1; r < 16; ++r) pmax = fmaxf(pmax, p0[r]);
#pragma unroll
  for (int r = 0; r < 16; ++r) pmax = fmaxf(pmax, p1[r]);
  { auto rr = __builtin_amdgcn_permlane32_swap(__float_as_uint(pmax), __float_as_uint(pmax), false, false);
    pmax = fmaxf(__uint_as_float(rr[0]), __uint_as_float(rr[1])); }
  if (__builtin_expect(__all(pmax - m_reg <= thr_raw), 1)) { mn = m_reg; alpha = 1.f; }
  else { mn = fmaxf(m_reg, pmax); alpha = __builtin_amdgcn_exp2f((m_reg - mn) * C); m_reg = mn; }
  const float mnC = -mn * C;
#pragma unroll
  for (int r = 0; r < 16; ++r) p0[r] = fmaf(p0[r], C, mnC);
#pragma unroll
  for (int r = 0; r < 16; ++r) p1[r] = fmaf(p1[r], C, mnC);
#pragma unroll
  for (int r = 0; r < 16; ++r) p0[r] = __builtin_amdgcn_exp2f(p0[r]);
}
__device__ __forceinline__ void finishSM(f32x16& p0, f32x16& p1, float alpha, float& l_reg, bf16x8& pa0, bf16x8& pa1, bf16x8& pa2, bf16x8& pa3) {
#pragma unroll
  for (int r = 0; r < 16; ++r) p1[r] = __builtin_amdgcn_exp2f(p1[r]);
  float ps = 0;
#pragma unroll
  for (int r = 0; r < 16; ++r) ps += p0[r];
#pragma unroll
  for (int r = 0; r < 16; ++r) ps += p1[r];
  { auto rr = __builtin_amdgcn_permlane32_swap(__float_as_uint(ps), __float_as_uint(ps), false, false);
    ps = __uint_as_float(rr[0]) + __uint_as_float(rr[1]); }
  l_reg = l_reg * alpha + ps;
#define FA_PK4(P, BASE, OUT) do { unsigned a0 = cvtpk(P[BASE + 0], P[BASE + 1]), a1 = cvtpk(P[BASE + 2], P[BASE + 3]);   \
    unsigned b0 = cvtpk(P[BASE + 4], P[BASE + 5]), b1 = cvtpk(P[BASE + 6], P[BASE + 7]);                              \
    auto r0 = __builtin_amdgcn_permlane32_swap(a0, b0, false, false); auto r1 = __builtin_amdgcn_permlane32_swap(a1, b1, false, false); \
    u32x4 w = {r0[0], r1[0], r0[1], r1[1]}; OUT = __builtin_bit_cast(bf16x8, w); } while (0)
  FA_PK4(p0, 0, pa0); FA_PK4(p0, 8, pa1); FA_PK4(p1, 0, pa2); FA_PK4(p1, 8, pa3);
#undef FA_PK4
}
template <int DQK>
__device__ __forceinline__ void qkt(f32x16& p0, f32x16& p1, const LAS char* Ks, const bf16x8* qr, int r32, int hi) {
  p0 = f32x16{}; p1 = f32x16{};
#pragma unroll
  for (int d0 = 0; d0 < DQK / 16; ++d0) { const int cb = (d0 * 16 + hi * 8) * 2;
    const bf16x8 b0 = *(const LAS bf16x8*)(Ks + kswz<DQK>(r32, cb));
    const bf16x8 b1 = *(const LAS bf16x8*)(Ks + kswz<DQK>(32 + r32, cb));
    p0 = __builtin_amdgcn_mfma_f32_32x32x16_bf16(b0, qr[d0], p0, 0, 0, 0);
    p1 = __builtin_amdgcn_mfma_f32_32x32x16_bf16(b1, qr[d0], p1, 0, 0, 0); }
}
template <int D0, int NB> __device__ __forceinline__ void pv_one(f32x16& od, int vb, bf16x8 pa0, bf16x8 pa1, bf16x8 pa2, bf16x8 pa3) {
#define FA_VO(ks, half) (((2 * (ks) + (half)) * NB + D0) * 512)
  const s16x4 l0 = tr_read<FA_VO(0, 0)>(vb), h0 = tr_read<FA_VO(0, 1)>(vb), l1 = tr_read<FA_VO(1, 0)>(vb), h1 = tr_read<FA_VO(1, 1)>(vb);
  const s16x4 l2 = tr_read<FA_VO(2, 0)>(vb), h2 = tr_read<FA_VO(2, 1)>(vb), l3 = tr_read<FA_VO(3, 0)>(vb), h3 = tr_read<FA_VO(3, 1)>(vb);
#undef FA_VO
  asm volatile("s_waitcnt lgkmcnt(0)" ::: "memory"); FA_SBAR();
#define FA_PK(L, H) (bf16x8){L[0], L[1], L[2], L[3], H[0], H[1], H[2], H[3]}
  od = __builtin_amdgcn_mfma_f32_32x32x16_bf16(pa0, FA_PK(l0, h0), od, 0, 0, 0);
  od = __builtin_amdgcn_mfma_f32_32x32x16_bf16(pa1, FA_PK(l1, h1), od, 0, 0, 0);
  od = __builtin_amdgcn_mfma_f32_32x32x16_bf16(pa2, FA_PK(l2, h2), od, 0, 0, 0);
  od = __builtin_amdgcn_mfma_f32_32x32x16_bf16(pa3, FA_PK(l3, h3), od, 0, 0, 0);
#undef FA_PK
}
template <int NB> __device__ __forceinline__ void pv_all(f32x16* o, int vb, bf16x8 pa0, bf16x8 pa1, bf16x8 pa2, bf16x8 pa3) {
  pv_one<0, NB>(o[0], vb, pa0, pa1, pa2, pa3); pv_one<1, NB>(o[1], vb, pa0, pa1, pa2, pa3);
  if constexpr (NB == 4) { pv_one<2, NB>(o[2], vb, pa0, pa1, pa2, pa3); pv_one<3, NB>(o[3], vb, pa0, pa1, pa2, pa3); }
}
template <int DQK, int DV, int SD, bool CVT>
__device__ __forceinline__ void attn_unit(const bf16* __restrict__ Qb, const int ldq, const bf16* __restrict__ Kh, const int ldk, const bf16* __restrict__ Vh, const int ldv,
                                          bf16* __restrict__ Ob, const int ldo, const int seq, const float scale, LAS char* lds, const Args& cva, unsigned char* cvws, int cv0, const int cv1, const int cvper) {
  constexpr int NB = DV / 32, NQ = DQK / 16, SHM_V = KVBLK * DV * 2, SHM_K = KVBLK * DQK * 2;
  constexpr int CPK = DQK / 8, CPV = DV / 8, PK = KVBLK * CPK / 512, PV = KVBLK * CPV / 512;
  static_assert(KVBLK * CPK % 512 == 0 && KVBLK * CPV % 512 == 0, "tile chunks must divide over 512 threads");
  const int tid = opq_tid(), wid = __builtin_amdgcn_readfirstlane(tid >> 6), lane = tid & 63, r32 = lane & 31, hi = lane >> 5;
  LAS char* V_lds = lds; LAS char* K_lds = lds + 2 * SHM_V;
  LAS float* wsf = (LAS float*)(lds + 2 * SHM_V + 2 * SHM_K) + wid * 64; LAS float* li_l = wsf; LAS float* al_l = wsf + 32;
  const float C = scale * 1.4426950408889634f, thr_raw = 8.f / scale;
  float m_reg = -1e30f, l_reg = 0; f32x16 o[NB]; bf16x8 qr[NQ];
#pragma unroll
  for (int d = 0; d < NB; ++d) o[d] = f32x16{};
  const bf16* Qw = Qb + (long)(wid * QBLK + r32) * ldq + hi * 8;
#pragma unroll
  for (int d0 = 0; d0 < NQ; ++d0) qr[d0] = *reinterpret_cast<const bf16x8*>(Qw + d0 * 16);
  int krow[PK], kcol[PK], vrow[PV], vcol[PV];
#pragma unroll
  for (int p = 0; p < PK; ++p) { const int idx = tid + 512 * p; krow[p] = idx / CPK; kcol[p] = (idx % CPK) * 8; }
#pragma unroll
  for (int p = 0; p < PV; ++p) { const int idx = tid + 512 * p; vrow[p] = idx / CPV; vcol[p] = (idx % CPV) * 8; }
  const int vb0 = (int)(uintptr_t)V_lds + v_rd_base(lane);
  bf16x8 sk[SD][PK], sv[SD][PV];
#define FA_SLOAD(i, k0) do { _Pragma("unroll") for (int p = 0; p < PV; ++p) sv[i][p] = *reinterpret_cast<const bf16x8*>(&Vh[(long)((k0) + vrow[p]) * ldv + vcol[p]]); \
    _Pragma("unroll") for (int p = 0; p < PK; ++p) sk[i][p] = *reinterpret_cast<const bf16x8*>(&Kh[(long)((k0) + krow[p]) * ldk + kcol[p]]); } while (0)
#define FA_SWRITE(b, i) do { _Pragma("unroll") for (int p = 0; p < PV; ++p) *(LAS bf16x8*)(V_lds + (b) * SHM_V + v_st<NB>(vrow[p], vcol[p])) = sv[i][p]; \
    _Pragma("unroll") for (int p = 0; p < PK; ++p) *(LAS bf16x8*)(K_lds + (b) * SHM_K + kswz<DQK>(krow[p], kcol[p] * 2)) = sk[i][p]; } while (0)
#define FA_RESC(a) do { if (__any((a) < 1.f)) { if (hi == 0) al_l[r32] = (a); asm volatile("s_waitcnt lgkmcnt(0)" ::: "memory"); \
    _Pragma("unroll") for (int d = 0; d < NB; ++d) _Pragma("unroll") for (int r = 0; r < 16; ++r) o[d][r] *= al_l[crow(r, hi)]; } } while (0)
  f32x16 pA0, pA1, pB0, pB1; float mnA, mnB, alA, alB; bf16x8 pa0, pa1, pa2, pa3; const int NT = seq / KVBLK;
  constexpr int SE = 0, SO = SD - 1;
  FA_SLOAD(SE, 0); asm volatile("s_waitcnt vmcnt(0)" ::: "memory"); FA_SWRITE(0, SE); __syncthreads();
  qkt<DQK>(pA0, pA1, K_lds, qr, r32, hi); partialSM(pA0, pA1, m_reg, mnA, alA, C, thr_raw);
  FA_SLOAD(SO, KVBLK); if constexpr (SD == 2) { if (2 < NT) FA_SLOAD(SE, 2 * KVBLK); }
  FA_SWRITE(1, SO); __syncthreads();
  f32x4 cvv[8]; CvtJob cvj; bool cvp = false; int cvt3 = 0;
  for (int j = 1; j + 1 < NT; j += 2) {
    if constexpr (CVT) {
      if (cvp) { cvt_store(cvj, wid, lane, cvv); cvp = false; }
      if (cvt3 == 0 && cv0 < cv1) { cvj = cvt_decode(cva, cvws, cv0); cvt_load(cvj, wid, lane, cvv); cvp = true; ++cv0; }
      cvt3 = cvt3 + 1 >= cvper ? 0 : cvt3 + 1;
    }
    FA_SBAR(); qkt<DQK>(pB0, pB1, K_lds + SHM_K, qr, r32, hi);
    finishSM(pA0, pA1, alA, l_reg, pa0, pa1, pa2, pa3); FA_SBAR();
    FA_SLOAD(SO, (j + SD) * KVBLK); FA_SBAR();
    pv_all<NB>(o, vb0, pa0, pa1, pa2, pa3); partialSM(pB0, pB1, m_reg, mnB, alB, C, thr_raw);
    __syncthreads(); FA_SWRITE(0, SE);
    FA_RESC(alB); __syncthreads();
    FA_SBAR(); qkt<DQK>(pA0, pA1, K_lds, qr, r32, hi);
    finishSM(pB0, pB1, alB, l_reg, pa0, pa1, pa2, pa3); FA_SBAR();
    if (SD == 1 || j + 3 < NT) FA_SLOAD(SE, (j + 1 + SD) * KVBLK); FA_SBAR();
    pv_all<NB>(o, vb0 + SHM_V, pa0, pa1, pa2, pa3); partialSM(pA0, pA1, m_reg, mnA, alA, C, thr_raw);
    __syncthreads(); FA_SWRITE(1, SO);
    FA_RESC(alA); __syncthreads();
  }
  if constexpr (CVT) { if (cvp) cvt_store(cvj, wid, lane, cvv); }
  FA_SBAR(); qkt<DQK>(pB0, pB1, K_lds + SHM_K, qr, r32, hi);
  finishSM(pA0, pA1, alA, l_reg, pa0, pa1, pa2, pa3); FA_SBAR();
  pv_all<NB>(o, vb0, pa0, pa1, pa2, pa3); partialSM(pB0, pB1, m_reg, mnB, alB, C, thr_raw);
  __syncthreads(); FA_RESC(alB);
  finishSM(pB0, pB1, alB, l_reg, pa0, pa1, pa2, pa3); FA_SBAR();
  pv_all<NB>(o, vb0 + SHM_V, pa0, pa1, pa2, pa3);
  if (hi == 0) li_l[r32] = l_reg; asm volatile("s_waitcnt lgkmcnt(0)" ::: "memory");
  float rli[16];
#pragma unroll
  for (int r = 0; r < 16; ++r) rli[r] = __builtin_amdgcn_rcpf(li_l[crow(r, hi)]);
  bf16* Ow = Ob + (long)(wid * QBLK) * ldo;
#pragma unroll
  for (int r = 0; r < 16; ++r) { const int orow = crow(r, hi);
#pragma unroll
    for (int d0 = 0; d0 < NB; ++d0) Ow[(long)orow * ldo + d0 * 32 + r32] = f2bf(o[d0][r] * rli[r]); }
  __syncthreads();
#undef FA_SLOAD
#undef FA_SWRITE
#undef FA_RESC
}
__device__ __forceinline__ void packP(const f32x16& p0, const f32x16& p1, bf16x8& pa0, bf16x8& pa1, bf16x8& pa2, bf16x8& pa3) {
#define FA_PK4(P, BASE, OUT) do { unsigned a0 = cvtpk(P[BASE + 0], P[BASE + 1]), a1 = cvtpk(P[BASE + 2], P[BASE + 3]);   \
    unsigned b0 = cvtpk(P[BASE + 4], P[BASE + 5]), b1 = cvtpk(P[BASE + 6], P[BASE + 7]);                              \
    auto r0 = __builtin_amdgcn_permlane32_swap(a0, b0, false, false); auto r1 = __builtin_amdgcn_permlane32_swap(a1, b1, false, false); \
    u32x4 w = {r0[0], r1[0], r0[1], r1[1]}; OUT = __builtin_bit_cast(bf16x8, w); } while (0)
  FA_PK4(p0, 0, pa0); FA_PK4(p0, 8, pa1); FA_PK4(p1, 0, pa2); FA_PK4(p1, 8, pa3);
#undef FA_PK4
}
template <int DQK>
__device__ __forceinline__ void qkt_init(f32x16& p0, f32x16& p1, const LAS char* Ks, const bf16x8* qr, int r32, int hi, const f32x16& init) {
  p0 = init; p1 = init;
#pragma unroll
  for (int d0 = 0; d0 < DQK / 16; ++d0) { const int cb = (d0 * 16 + hi * 8) * 2;
    const bf16x8 b0 = *(const LAS bf16x8*)(Ks + kswz<DQK>(r32, cb));
    const bf16x8 b1 = *(const LAS bf16x8*)(Ks + kswz<DQK>(32 + r32, cb));
    p0 = __builtin_amdgcn_mfma_f32_32x32x16_bf16(b0, qr[d0], p0, 0, 0, 0);
    p1 = __builtin_amdgcn_mfma_f32_32x32x16_bf16(b1, qr[d0], p1, 0, 0, 0); }
}
template <int NB> __device__ __forceinline__ void pv_sum(f32x16* o, int vb, bf16x8 pa0, bf16x8 pa1, bf16x8 pa2, bf16x8 pa3) {
  const bf16x8 ones = {0x3F80, 0x3F80, 0x3F80, 0x3F80, 0x3F80, 0x3F80, 0x3F80, 0x3F80};
  pv_all<NB>(o, vb, pa0, pa1, pa2, pa3);
  o[NB] = __builtin_amdgcn_mfma_f32_32x32x16_bf16(pa0, ones, o[NB], 0, 0, 0); o[NB] = __builtin_amdgcn_mfma_f32_32x32x16_bf16(pa1, ones, o[NB], 0, 0, 0);
  o[NB] = __builtin_amdgcn_mfma_f32_32x32x16_bf16(pa2, ones, o[NB], 0, 0, 0); o[NB] = __builtin_amdgcn_mfma_f32_32x32x16_bf16(pa3, ones, o[NB], 0, 0, 0);
}
template <int DQK, int DV, int SD, bool CVT>
__device__ __forceinline__ void attn_unit_fixed(const bf16* __restrict__ Qb, const int ldq, const bf16* __restrict__ Kh, const int ldk, const bf16* __restrict__ Vh, const int ldv,
                                                bf16* __restrict__ Ob, const int ldo, const int seq, LAS char* lds, const Args& cva, unsigned char* cvws, int cv0, const int cv1, const int cvper) {
  constexpr int NB = DV / 32, NQ = DQK / 16, SHM_V = KVBLK * DV * 2, SHM_K = KVBLK * DQK * 2;
  constexpr int CPK = DQK / 8, CPV = DV / 8, PK = KVBLK * CPK / 512, PV = KVBLK * CPV / 512;
  static_assert(KVBLK * CPK % 512 == 0 && KVBLK * CPV % 512 == 0, "tile chunks must divide over 512 threads");
  const int tid = opq_tid(), wid = __builtin_amdgcn_readfirstlane(tid >> 6), lane = tid & 63, r32 = lane & 31, hi = lane >> 5;
  LAS char* V_lds = lds; LAS char* K_lds = lds + 3 * SHM_V;
  static_assert(SD == 2, "two staging slots");
  f32x16 o[NB + 1]; bf16x8 qr[NQ];
#pragma unroll
  for (int d = 0; d <= NB; ++d) o[d] = f32x16{};
  const bf16* Qw = Qb + (long)(wid * QBLK + r32) * ldq + hi * 8;
#pragma unroll
  for (int d0 = 0; d0 < NQ; ++d0) qr[d0] = *reinterpret_cast<const bf16x8*>(Qw + d0 * 16);
  int krow[PK], kcol[PK], vrow[PV], vcol[PV];
#pragma unroll
  for (int p = 0; p < PK; ++p) { const int idx = tid + 512 * p; krow[p] = idx / CPK; kcol[p] = (idx % CPK) * 8; }
#pragma unroll
  for (int p = 0; p < PV; ++p) { const int idx = tid + 512 * p; vrow[p] = idx / CPV; vcol[p] = (idx % CPV) * 8; }
  const int vb0 = (int)(uintptr_t)V_lds + v_rd_base(lane);
  bf16x8 sk[SD][PK], sv[SD][PV];
#define FA_SLOAD(i, k0) do { _Pragma("unroll") for (int p = 0; p < PV; ++p) sv[i][p] = *(const GAS bf16x8*)(&Vh[(long)((k0) + vrow[p]) * ldv + vcol[p]]); \
    _Pragma("unroll") for (int p = 0; p < PK; ++p) sk[i][p] = *(const GAS bf16x8*)(&Kh[(long)((k0) + krow[p]) * ldk + kcol[p]]); } while (0)
#define FA_SWRITE(b, i) do { _Pragma("unroll") for (int p = 0; p < PV; ++p) *(LAS bf16x8*)(V_lds + (b) * SHM_V + v_st<NB>(vrow[p], vcol[p])) = sv[i][p]; \
    _Pragma("unroll") for (int p = 0; p < PK; ++p) *(LAS bf16x8*)(K_lds + (b) * SHM_K + kswz<DQK>(krow[p], kcol[p] * 2)) = sk[i][p]; } while (0)
#define FA_EXP(P) do { _Pragma("unroll") for (int r = 0; r < 16; ++r) P[r] = __builtin_amdgcn_exp2f(P[r]); } while (0)
  f32x16 pA0, pA1, pB0, pB1; bf16x8 pa0, pa1, pa2, pa3; const int NT = seq / KVBLK;
  constexpr int SE = 0, SO = SD - 1;
  FA_SLOAD(SE, 0); asm volatile("s_waitcnt vmcnt(0)" ::: "memory"); FA_SWRITE(0, SE); __syncthreads();
  qkt<DQK>(pA0, pA1, K_lds, qr, r32, hi); FA_EXP(pA0);
  FA_SLOAD(SO, KVBLK); if (2 < NT) FA_SLOAD(SE, 2 * KVBLK);
  FA_SWRITE(1, SO); __syncthreads();
  __builtin_amdgcn_s_waitcnt(0x0F70);
  int bP = 0, bK = 1, bN = 2;
#define FA_ROT() do { const int t_ = bP; bP = bK; bK = bN; bN = t_; } while (0)
  f32x4 cvv[8]; CvtJob cvj; bool cvp = false; int cvt3 = 0;
  for (int j = 1; j + 1 < NT; j += 2) {
    if constexpr (CVT) {
      if (cvp) { cvt_store(cvj, wid, lane, cvv); cvp = false; }
      if (cvt3 == 0 && cv0 < cv1) { cvj = cvt_decode(cva, cvws, cv0); cvt_load(cvj, wid, lane, cvv); cvp = true; ++cv0; }
      cvt3 = cvt3 + 1 >= cvper ? 0 : cvt3 + 1;
    }
    FA_SBAR(); qkt<DQK>(pB0, pB1, K_lds + bK * SHM_K, qr, r32, hi);
    FA_EXP(pA1); packP(pA0, pA1, pa0, pa1, pa2, pa3); FA_SBAR();
    FA_SLOAD(SO, (j + 2) * KVBLK); FA_SBAR();
    pv_sum<NB>(o, vb0 + bP * SHM_V, pa0, pa1, pa2, pa3); FA_EXP(pB0);
    FA_SWRITE(bN, SE);
    __syncthreads(); FA_ROT();
    if (j + 3 < NT) FA_SLOAD(SE, (j + 3) * KVBLK);
    FA_SBAR(); qkt<DQK>(pA0, pA1, K_lds + bK * SHM_K, qr, r32, hi);
    FA_EXP(pB1); packP(pB0, pB1, pa0, pa1, pa2, pa3); FA_SBAR();
    pv_sum<NB>(o, vb0 + bP * SHM_V, pa0, pa1, pa2, pa3); FA_EXP(pA0);
    FA_SWRITE(bN, SO);
    __syncthreads(); FA_ROT();
  }
  if constexpr (CVT) { if (cvp) cvt_store(cvj, wid, lane, cvv); }
  FA_SBAR(); qkt<DQK>(pB0, pB1, K_lds + bK * SHM_K, qr, r32, hi);
  FA_EXP(pA1); packP(pA0, pA1, pa0, pa1, pa2, pa3); FA_SBAR();
  pv_sum<NB>(o, vb0 + bP * SHM_V, pa0, pa1, pa2, pa3); FA_EXP(pB0);
  FA_EXP(pB1); packP(pB0, pB1, pa0, pa1, pa2, pa3); FA_SBAR();
  pv_sum<NB>(o, vb0 + bK * SHM_V, pa0, pa1, pa2, pa3);
#undef FA_ROT
  bf16* Ow = Ob + (long)(wid * QBLK) * ldo;
#pragma unroll
  for (int r = 0; r < 16; ++r) { const int orow = crow(r, hi); const float rl = __builtin_amdgcn_rcpf(o[NB][r]);
#pragma unroll
    for (int d0 = 0; d0 < NB; ++d0) Ow[(long)orow * ldo + d0 * 32 + r32] = f2bf(o[d0][r] * rl); }
  __syncthreads();
#undef FA_SLOAD
#undef FA_SWRITE
#undef FA_EXP
}
template <int DQK, int DV>
__device__ __forceinline__ void attn_unit_single(const bf16* __restrict__ Qb, const int ldq, const bf16* __restrict__ Kh, const int ldk, const bf16* __restrict__ Vh, const int ldv,
                                                 bf16* __restrict__ Ob, const int ldo, const int seq, const float scale, LAS char* lds) {
  constexpr int NB = DV / 32, NQ = DQK / 16, SHM_V = KVBLK * DV * 2, SHM_K = KVBLK * DQK * 2;
  constexpr int CPK = DQK / 8, CPV = DV / 8, PK = KVBLK * CPK / 512, PV = KVBLK * CPV / 512;
  static_assert(KVBLK * CPK % 512 == 0 && KVBLK * CPV % 512 == 0, "tile chunks must divide over 512 threads");
  const int tid = opq_tid(), wid = tid >> 6, lane = tid & 63, r32 = lane & 31, hi = lane >> 5;
  LAS char* V_lds = lds; LAS char* K_lds = lds + 2 * SHM_V;
  LAS float* wsf = (LAS float*)(lds + 2 * SHM_V + 2 * SHM_K) + wid * 64; LAS float* li_l = wsf; LAS float* al_l = wsf + 32;
  const float C = scale * 1.4426950408889634f, thr_raw = 8.f / scale;
  float m_reg = -1e30f, l_reg = 0; f32x16 o[NB]; bf16x8 qr[NQ];
#pragma unroll
  for (int d = 0; d < NB; ++d) o[d] = f32x16{};
  const bf16* Qw = Qb + (long)(wid * QBLK + r32) * ldq + hi * 8;
#pragma unroll
  for (int d0 = 0; d0 < NQ; ++d0) qr[d0] = *reinterpret_cast<const bf16x8*>(Qw + d0 * 16);
  const int vb0 = (int)(uintptr_t)V_lds + v_rd_base(lane);
  bf16x8 sk[PK], sv[PV];
#define FA_SLOAD(k0) do { int t_ = tid; asm volatile("" : "+v"(t_)); \
    _Pragma("unroll") for (int p = 0; p < PV; ++p) { const int idx = t_ + 512 * p; sv[p] = *reinterpret_cast<const bf16x8*>(&Vh[(long)((k0) + idx / CPV) * ldv + (idx % CPV) * 8]); } \
    _Pragma("unroll") for (int p = 0; p < PK; ++p) { const int idx = t_ + 512 * p; sk[p] = *reinterpret_cast<const bf16x8*>(&Kh[(long)((k0) + idx / CPK) * ldk + (idx % CPK) * 8]); } } while (0)
#define FA_SWRITE(b) do { int t_ = tid; asm volatile("" : "+v"(t_)); \
    _Pragma("unroll") for (int p = 0; p < PV; ++p) { const int idx = t_ + 512 * p; *(LAS bf16x8*)(V_lds + (b) * SHM_V + v_st<NB>(idx / CPV, (idx % CPV) * 8)) = sv[p]; } \
    _Pragma("unroll") for (int p = 0; p < PK; ++p) { const int idx = t_ + 512 * p; *(LAS bf16x8*)(K_lds + (b) * SHM_K + kswz<DQK>(idx / CPK, (idx % CPK) * 16)) = sk[p]; } } while (0)
  f32x16 p0, p1; float mn, al; bf16x8 pa0, pa1, pa2, pa3; const int NT = seq / KVBLK;
  FA_SLOAD(0); FA_SWRITE(0); __syncthreads();
  FA_SLOAD(KVBLK);
  for (int j = 0; j < NT; ++j) {
    const int b = j & 1;
    FA_SBAR(); qkt<DQK>(p0, p1, K_lds + b * SHM_K, qr, r32, hi);
    partialSM(p0, p1, m_reg, mn, al, C, thr_raw);
    if (__any(al < 1.f)) { if (hi == 0) al_l[r32] = al; asm volatile("s_waitcnt lgkmcnt(0)" ::: "memory");
#pragma unroll
      for (int d = 0; d < NB; ++d)
#pragma unroll
        for (int r = 0; r < 16; ++r) o[d][r] *= al_l[crow(r, hi)]; }
    finishSM(p0, p1, al, l_reg, pa0, pa1, pa2, pa3); FA_SBAR();
    if (j + 1 < NT) FA_SWRITE(b ^ 1);
    FA_SBAR();
    pv_all<NB>(o, vb0 + b * SHM_V, pa0, pa1, pa2, pa3);
    __syncthreads();
    if (j + 2 < NT) FA_SLOAD((j + 2) * KVBLK);
  }
  if (hi == 0) li_l[r32] = l_reg; asm volatile("s_waitcnt lgkmcnt(0)" ::: "memory");
  float rli[16];
#pragma unroll
  for (int r = 0; r < 16; ++r) rli[r] = __builtin_amdgcn_rcpf(li_l[crow(r, hi)]);
  bf16* Ow = Ob + (long)(wid * QBLK) * ldo;
#pragma unroll
  for (int r = 0; r < 16; ++r) { const int orow = crow(r, hi);
#pragma unroll
    for (int d0 = 0; d0 < NB; ++d0) Ow[(long)orow * ldo + d0 * 32 + r32] = f2bf(o[d0][r] * rli[r]); }
  __syncthreads();
#undef FA_SLOAD
#undef FA_SWRITE
}
template <int DQK, int DV, int NQL>
__device__ __forceinline__ void attn_unit_fixed_ql(const bf16* __restrict__ Qb, const int ldq, const bf16* __restrict__ Kh, const int ldk, const bf16* __restrict__ Vh, const int ldv,
                                                   bf16* __restrict__ Ob, const int ldo, const int seq, LAS char* lds, const Args& cva, unsigned char* cvws, int cv0, const int cv1, const int cvper) {
  constexpr int NB = DV / 32, NQ = DQK / 16, NQR = NQ - NQL, SHM_V = KVBLK * DV * 2, SHM_K = KVBLK * DQK * 2;
  constexpr int CPK = DQK / 8, CPV = DV / 8, PK = KVBLK * CPK / 512, PV = KVBLK * CPV / 512;
  static_assert(KVBLK * CPK % 512 == 0 && KVBLK * CPV % 512 == 0 && NQL == 4, "tile chunks must divide over 512 threads; 4 LDS fragments = 128-byte rows");
  const int tid = opq_tid(), wid = tid >> 6, lane = tid & 63, r32 = lane & 31, hi = lane >> 5;
  LAS char* V_lds = lds; LAS char* K_lds = lds + 2 * SHM_V;
  LAS float* li_l = (LAS float*)(lds + 2 * SHM_V + 2 * SHM_K) + wid * 64;
  LAS char* Qls = lds + 2 * SHM_V + 2 * SHM_K + 2048 + wid * 4096;
  float l_reg = 0.f; f32x16 o[NB]; bf16x8 qr[NQR];
#pragma unroll
  for (int d = 0; d < NB; ++d) o[d] = f32x16{};
  const bf16* Qw = Qb + (long)(wid * QBLK + r32) * ldq + hi * 8;
#pragma unroll
  for (int d0 = 0; d0 < NQR; ++d0) qr[d0] = *reinterpret_cast<const bf16x8*>(Qw + d0 * 16);
#pragma unroll
  for (int i = 0; i < NQL; ++i) *(LAS bf16x8*)(Qls + kswz<64>(r32, i * 32 + hi * 16)) = *reinterpret_cast<const bf16x8*>(Qw + (NQR + i) * 16);
  int kq[4];
#pragma unroll
  for (int i = 0; i < 4; ++i) kq[i] = r32 * (2 * DQK) + ((32 * i + 16 * hi) ^ (((r32 >> 1) & 7) << 4));
  static_assert((2 * DQK) % 128 == 0, "K rows are whole 128-byte groups");
  const int vb0 = (int)(uintptr_t)V_lds + v_rd_base(lane);
  bf16x8 sk[PK], sv[PV];
#define FA_SLOAD(k0) do { int t_ = tid; asm volatile("" : "+v"(t_)); \
    _Pragma("unroll") for (int p = 0; p < PV; ++p) { const int idx = t_ + 512 * p; sv[p] = *reinterpret_cast<const bf16x8*>(&Vh[(long)((k0) + idx / CPV) * ldv + (idx % CPV) * 8]); } \
    _Pragma("unroll") for (int p = 0; p < PK; ++p) { const int idx = t_ + 512 * p; sk[p] = *reinterpret_cast<const bf16x8*>(&Kh[(long)((k0) + idx / CPK) * ldk + (idx % CPK) * 8]); } } while (0)
#define FA_SWRITE(b) do { int t_ = tid; asm volatile("" : "+v"(t_)); \
    _Pragma("unroll") for (int p = 0; p < PV; ++p) { const int idx = t_ + 512 * p; *(LAS bf16x8*)(V_lds + (b) * SHM_V + v_st<NB>(idx / CPV, (idx % CPV) * 8)) = sv[p]; } \
    _Pragma("unroll") for (int p = 0; p < PK; ++p) { const int idx = t_ + 512 * p; *(LAS bf16x8*)(K_lds + (b) * SHM_K + kswz<DQK>(idx / CPK, (idx % CPK) * 16)) = sk[p]; } } while (0)
  f32x16 p0, p1; bf16x8 pa0, pa1, pa2, pa3; const int NT = seq / KVBLK;
  FA_SLOAD(0); FA_SWRITE(0); __syncthreads();
  FA_SLOAD(KVBLK);
  f32x4 cvv[8]; CvtJob cvj; bool cvp = false; int cvt3 = 0; const int widu = __builtin_amdgcn_readfirstlane(wid);
  for (int j = 0; j < NT; ++j) {
    if (cvp && cvt3 == 0) { cvt_store(cvj, widu, lane, cvv); cvp = false; }
    if (cvt3 == 0 && cv0 < cv1) { cvj = cvt_decode(cva, cvws, cv0); cvt_load(cvj, widu, lane, cvv); cvp = true; ++cv0; }
    cvt3 = cvt3 + 1 >= cvper ? 0 : cvt3 + 1;
    const int b = j & 1; const LAS char* Ks = K_lds + b * SHM_K;
    FA_SBAR(); p0 = f32x16{}; p1 = f32x16{};
#pragma unroll
    for (int d0 = 0; d0 < NQ; ++d0) {
      const bf16x8 b0 = *(const LAS bf16x8*)(Ks + kq[d0 & 3] + (d0 >> 2) * 128); const bf16x8 b1 = *(const LAS bf16x8*)(Ks + kq[d0 & 3] + (d0 >> 2) * 128 + 32 * 2 * DQK);
      bf16x8 qf; if (d0 < NQR) qf = qr[d0 < NQR ? d0 : 0]; else qf = *(const LAS bf16x8*)(Qls + kswz<64>(r32, (d0 - NQR) * 32 + hi * 16));
      p0 = __builtin_amdgcn_mfma_f32_32x32x16_bf16(b0, qf, p0, 0, 0, 0); p1 = __builtin_amdgcn_mfma_f32_32x32x16_bf16(b1, qf, p1, 0, 0, 0); }
#pragma unroll
    for (int r = 0; r < 16; ++r) { p0[r] = __builtin_amdgcn_exp2f(p0[r]); l_reg += p0[r]; }
#pragma unroll
    for (int r = 0; r < 16; ++r) { p1[r] = __builtin_amdgcn_exp2f(p1[r]); l_reg += p1[r]; }
    packP(p0, p1, pa0, pa1, pa2, pa3); FA_SBAR();
    if (j + 1 < NT) FA_SWRITE(b ^ 1);
    FA_SBAR();
    pv_all<NB>(o, vb0 + b * SHM_V, pa0, pa1, pa2, pa3);
    __syncthreads();
    if (j + 2 < NT) FA_SLOAD((j + 2) * KVBLK);
  }
  if (cvp) cvt_store(cvj, widu, lane, cvv);
  { auto rr = __builtin_amdgcn_permlane32_swap(__float_as_uint(l_reg), __float_as_uint(l_reg), false, false); l_reg = __uint_as_float(rr[0]) + __uint_as_float(rr[1]); }
  if (hi == 0) li_l[r32] = l_reg; asm volatile("s_waitcnt lgkmcnt(0)" ::: "memory");
  bf16* Ow = Ob + (long)(wid * QBLK) * ldo;
#pragma unroll
  for (int r = 0; r < 16; ++r) { const int orow = crow(r, hi); const float rl = __builtin_amdgcn_rcpf(li_l[orow]);
#pragma unroll
    for (int d0 = 0; d0 < NB; ++d0) Ow[(long)orow * ldo + d0 * 32 + r32] = f2bf(o[d0][r] * rl); }
  __syncthreads();
#undef FA_SLOAD
#undef FA_SWRITE
}
}


__device__ __forceinline__ void ph_modulate(const Frame& F, const float* X, const float* shift, const float* scale, bf16* U) {
    for (int t = F.gw; t < S; t += F.ngw) {
        int j0 = 4 * F.lane; asm volatile("" : "+v"(j0));
#pragma unroll
        for (int i = 0; i < 8; ++i) { const int j = j0 + 256 * i;
            const f32x4 x = *(const f32x4*)(X + (size_t)t * D + j), sc = *(const f32x4*)(scale + j), sh = *(const f32x4*)(shift + j);
            v2u o; o.x = (unsigned)f2bf(x.x * (1.f + sc.x) + sh.x) | ((unsigned)f2bf(x.y * (1.f + sc.y) + sh.y) << 16);
            o.y = (unsigned)f2bf(x.z * (1.f + sc.z) + sh.z) | ((unsigned)f2bf(x.w * (1.f + sc.w) + sh.w) << 16);
            *(v2u*)(U + (size_t)t * D + j) = o; }
    }
}
__device__ __forceinline__ void rope_cs(int t, int lane, float& cs, float& sn) {
    const int i = lane & 15; const float pos = (float)((lane < 32) ? (t >> 6) : (t & 63));
    const float invf = exp2f(-(float)i * (13.287712379549449f / 16.f));
    const float ang = pos * invf; cs = cosf(ang); sn = sinf(ang);
}
__device__ __forceinline__ float rope_lane(float y, int lane, float cs, float sn) { const float p = __shfl_xor(y, 16); return (lane & 16) ? (y * cs + p * sn) : (y * cs - p * sn); }

__device__ __forceinline__ void ph_rope_table(const Frame& F) {
    float* RT = (float*)(F.ws + O_ROPE);
    for (int t = F.gw; t < S; t += F.ngw) { if (F.lane < 32) { float cs, sn; rope_cs(t, F.lane < 16 ? F.lane : F.lane + 16, cs, sn);
        RT[(size_t)t * 64 + (F.lane >> 4) * 32 + (F.lane & 15)] = cs; RT[(size_t)t * 64 + (F.lane >> 4) * 32 + 16 + (F.lane & 15)] = sn; } }
}
__device__ __forceinline__ f32x4 ld4bf(const bf16* p) { const v2u w = *(const v2u*)p; return (f32x4){__uint_as_float(w.x << 16), __uint_as_float(w.x & 0xffff0000u), __uint_as_float(w.y << 16), __uint_as_float(w.y & 0xffff0000u)}; }
__device__ __forceinline__ float grp16_sum(float v) { v += __shfl_xor(v, 1); v += __shfl_xor(v, 2); v += __shfl_xor(v, 4); v += __shfl_xor(v, 8); return v; }
__device__ __forceinline__ float dot4(f32x4 x) { return (x.x * x.x + x.y * x.y) + (x.z * x.z + x.w * x.w); }
__device__ __forceinline__ f32x4 rope4(f32x4 y, int lane, f32x4 cs, f32x4 sn) {
    f32x4 p; p.x = __shfl_xor(y.x, 4); p.y = __shfl_xor(y.y, 4); p.z = __shfl_xor(y.z, 4); p.w = __shfl_xor(y.w, 4);
    return (lane & 4) ? (y * cs + p * sn) : (y * cs - p * sn);
}
__device__ __forceinline__ v2u pack4(f32x4 v) { v2u o; o.x = pg8::cvt_pk_bf16(v.x, v.y); o.y = pg8::cvt_pk_bf16(v.z, v.w); return o; }
__device__ __forceinline__ void ph_post(const Frame& F, const Args& a, int l) {
    const float* gqn = LIN(3); const float* gkn = LIN(4); const float* mqn = LIN(5); const float* mkvn = LIN(7);
    const float* cw = LIN(9);
    const bf16* RAW = (const bf16*)(F.ws + O_RAW); const float* RT = (const float*)(F.ws + O_ROPE);
    bf16* QG = (bf16*)(F.ws + O_QG); bf16* KG = (bf16*)(F.ws + O_KG); bf16* VG = (bf16*)(F.ws + O_VG);
    bf16* CQ = (bf16*)(F.ws + O_CQ); bf16* CKV = (bf16*)(F.ws + O_CKV); bf16* KM = (bf16*)(F.ws + O_KM);
    bf16* MQ = (bf16*)(F.ws + O_MQ); bf16* MK = (bf16*)(F.ws + O_MK); bf16* MV = (bf16*)(F.ws + O_MV);
    const int lane = F.lane;
    const f32x4 gq4 = *(const f32x4*)(gqn + 4 * (lane & 15)), gk4 = *(const f32x4*)(gkn + 4 * (lane & 15));
    for (int t = F.gw; t < S; t += F.ngw) {
        int lo_ = 4 * lane; asm volatile("" : "+v"(lo_));
        const bf16* raw = RAW + (size_t)t * DINP + lo_;
        f32x4 v[16], xm[5], xp[5];
#pragma unroll
        for (int i = 0; i < 16; ++i) v[i] = ld4bf(raw + 256 * i);
        const bool hm = t > 0, hp = t < S - 1; const f32x4 z4 = {0.f, 0.f, 0.f, 0.f};
#pragma unroll
        for (int i = 0; i < 5; ++i) { xm[i] = hm ? ld4bf(raw + 256 * (9 + i) - DINP) : z4; xp[i] = hp ? ld4bf(raw + 256 * (9 + i) + DINP) : z4; }
        const float* rt = RT + (size_t)t * 64 + ((lane >> 3) & 1) * 32 + 4 * (lane & 3);
        const f32x4 cs = *(const f32x4*)rt, sn = *(const f32x4*)(rt + 16);
#pragma unroll
        for (int i = 0; i < 4; ++i) { const float r = 1.f / sqrtf(grp16_sum(dot4(v[i])) * (1.f / 64.f) + 1e-6f);
            *(v2u*)(QG + (size_t)t * 1024 + 256 * i + lo_) = pack4(rope4(v[i] * r * gq4, lane, cs, sn) * GQA_QSCALE); }
        { const float r = 1.f / sqrtf(grp16_sum(dot4(v[4])) * (1.f / 64.f) + 1e-6f);
          *(v2u*)(KG + (size_t)t * 256 + lo_) = pack4(rope4(v[4] * r * gk4, lane, cs, sn)); *(v2u*)(VG + (size_t)t * 256 + lo_) = pack4(v[5]); }
        { const float r = 1.f / sqrtf(wave_sum(dot4(v[6]) + dot4(v[7])) * (1.f / 512.f) + 1e-6f);
          *(v2u*)(CQ + (size_t)t * 512 + lo_) = pack4(v[6] * r * *(const f32x4*)(mqn + lo_)); *(v2u*)(CQ + (size_t)t * 512 + 256 + lo_) = pack4(v[7] * r * *(const f32x4*)(mqn + 256 + lo_)); }
        { const float r = 1.f / sqrtf(wave_sum(dot4(v[8])) * (1.f / 256.f) + 1e-6f);
          *(v2u*)(CKV + (size_t)t * 256 + lo_) = pack4(v[8] * r * *(const f32x4*)(mkvn + lo_)); }
        { const v2u o = pack4(rope4(v[9], lane, cs, sn));
          if (lane < 16) {
#pragma unroll
              for (int h = 0; h < 4; ++h) *(v2u*)(KM + (size_t)t * 768 + h * 192 + 128 + lo_) = o; } }
#pragma unroll
        for (int i = 0; i < 5; ++i) { const int m = 256 * (9 + i) + lo_ - C_MQ;
            if (m >= 0 && m < 1024) { const f32x4 x = *(const f32x4*)(cw + m) * xm[i] + *(const f32x4*)(cw + 1024 + m) * v[9 + i] + *(const f32x4*)(cw + 2048 + m) * xp[i];
                const f32x4 sv = {siluf(x.x), siluf(x.y), siluf(x.z), siluf(x.w)};
                if (m < 512) *(v2u*)(MQ + (size_t)t * 512 + m) = pack4(sv); else *(v2u*)(MK + (size_t)t * 512 + m - 512) = pack4(sv * 0.08838834764831845f); } }
#pragma unroll
        for (int i = 13; i < 16; ++i) { const int m = 256 * i + lo_ - C_MV; if (m >= 0 && m < 512) *(v2u*)(MV + (size_t)t * 512 + m) = pack4(v[i]); }
    }
}
__device__ __forceinline__ void ph_mlapost(const Frame& F, const int layer) {
    const bf16* RQ = (const bf16*)(F.ws + O_RAWQ); const bf16* RKV = (const bf16*)(F.ws + O_RAWKV);
    bf16* QM = (bf16*)(F.ws + O_QM); bf16* KM = (bf16*)(F.ws + O_KM); bf16* VM = (bf16*)(F.ws + O_VM);
    const int lane = F.lane, lo = 4 * lane;
    float mq[4] = {0.f, 0.f, 0.f, 0.f}, mk[4] = {0.f, 0.f, 0.f, 0.f};
    for (int t = F.gw; t < S; t += F.ngw) {
        const float* rt = (const float*)(F.ws + O_ROPE) + (size_t)t * 64 + ((lane >> 3) & 1) * 32 + 4 * (lane & 3);
        const f32x4 cs = *(const f32x4*)rt, sn = *(const f32x4*)(rt + 16);
        const bf16* rq = RQ + (size_t)t * 768 + lo; const bf16* rkv = RKV + (size_t)t * 1024 + lo;
        f32x4 q[3], kv[4];
#pragma unroll
        for (int i = 0; i < 3; ++i) q[i] = ld4bf(rq + 256 * i) * MLA_QSCALE;
#pragma unroll
        for (int i = 0; i < 4; ++i) kv[i] = ld4bf(rkv + 256 * i);
        const f32x4 kr = (lane < 16) ? ld4bf(KM + (size_t)t * 768 + 128 + lo) : (f32x4){0.f, 0.f, 0.f, 0.f};
        const float krn2 = wave_sum(dot4(kr));
        const int g16 = lane >> 4;
        v2u qo[3];
#pragma unroll
        for (int i = 0; i < 3; ++i) { const f32x4 r = rope4(q[i], lane, cs, sn);
            const bool isr = (i == 0 && g16 == 2) || (i == 1 && g16 == 1) || (i == 2 && (g16 == 0 || g16 == 3));
            qo[i] = pack4(isr ? r : q[i]); *(v2u*)(QM + (size_t)t * 768 + 256 * i + lo) = qo[i]; }
        float qs[3];
#pragma unroll
        for (int i = 0; i < 3; ++i) { const f32x4 b = {__uint_as_float(qo[i].x << 16), __uint_as_float(qo[i].x & 0xffff0000u), __uint_as_float(qo[i].y << 16), __uint_as_float(qo[i].y & 0xffff0000u)}; qs[i] = dot4(b); }
        const float h0 = wave_sum(g16 < 3 ? qs[0] : 0.f), h1 = wave_sum((g16 == 3 ? qs[0] : 0.f) + (g16 < 2 ? qs[1] : 0.f));
        const float h2 = wave_sum((g16 >= 2 ? qs[1] : 0.f) + (g16 == 0 ? qs[2] : 0.f)), h3 = wave_sum(g16 >= 1 ? qs[2] : 0.f);
        mq[0] = fmaxf(mq[0], h0); mq[1] = fmaxf(mq[1], h1); mq[2] = fmaxf(mq[2], h2); mq[3] = fmaxf(mq[3], h3);
#pragma unroll
        for (int h = 0; h < 4; ++h) { const v2u w = pack4(kv[h]);
            if (lane < 32) *(v2u*)(KM + (size_t)t * 768 + h * 192 + lo) = w; else *(v2u*)(VM + (size_t)t * 512 + h * 128 + lo - 128) = w;
            const f32x4 b = {__uint_as_float(w.x << 16), __uint_as_float(w.x & 0xffff0000u), __uint_as_float(w.y << 16), __uint_as_float(w.y & 0xffff0000u)};
            mk[h] = fmaxf(mk[h], wave_sum(lane < 32 ? dot4(b) : 0.f) + krn2); }
    }
    LAS float* red = (LAS float*)F.lds;
    if (lane == 0) {
#pragma unroll
        for (int h = 0; h < 4; ++h) { red[F.wave * 8 + 2 * h] = mq[h]; red[F.wave * 8 + 2 * h + 1] = mk[h]; } }
    __syncthreads();
    if (F.tid < 8) { float m = red[F.tid];
#pragma unroll
        for (int w = 1; w < NWAVES; ++w) m = fmaxf(m, red[w * 8 + F.tid]);
        ((float*)(F.ws + O_MLAB))[F.bid * 8 + F.tid] = m; }
    __syncthreads();
}
__device__ __forceinline__ bool mla_bounds_ok(const Frame& F) {
    const float* MB = (const float*)(F.ws + O_MLAB); float m[8];
#pragma unroll
    for (int i = 0; i < 8; ++i) m[i] = 0.f;
    for (int b = F.lane; b < F.nblk; b += 64) {
#pragma unroll
        for (int i = 0; i < 8; ++i) m[i] = fmaxf(m[i], MB[b * 8 + i]); }
    bool ok = true;
#pragma unroll
    for (int h = 0; h < 4; ++h) ok = ok && (sqrtf(wave_max(m[2 * h])) * sqrtf(wave_max(m[2 * h + 1])) < 80.f);
    return __builtin_amdgcn_readfirstlane((int)ok) != 0;
}
template <bool MLAFIX>
__device__ __forceinline__ void ph_fattn(const Frame& F, const Args& a, const int layer, const float* gqn, const float* gkn) {
    const bf16* QG = (const bf16*)(F.ws + O_QG); const bf16* KG = (const bf16*)(F.ws + O_KG); const bf16* VG = (const bf16*)(F.ws + O_VG);
    const bf16* QM = (const bf16*)(F.ws + O_QM); const bf16* KM = (const bf16*)(F.ws + O_KM); const bf16* VM = (const bf16*)(F.ws + O_VM);
    bf16* MIX = (bf16*)(F.ws + O_MIX);
    LAS char* lds = (LAS char*)F.lds;
    const int c = F.bid;
    if (MLAFIX && F.nblk >= 128) {
        if (c < 128) { const int h = c & 3, qb = c >> 2;
            const int m0 = layer ? CVT_L1 + c * CVT_M1 : CVT_EARLY + c * CVT_M0; int m1 = m0 + (layer ? CVT_M1 : CVT_M0); if (m1 > CVT_ITEMS) m1 = CVT_ITEMS;
            fa::attn_unit_fixed_ql<192, 128, 4>(QM + (size_t)qb * 256 * 768 + h * 192, 768, KM + h * 192, 768, VM + h * 128, 512, MIX + (size_t)qb * 256 * D + 1024 + h * 128, D, S, lds, a, F.ws, m0 < m1 ? m0 : m1, m1, layer ? 6 : 4); }
    } else {
        for (int u = c; u < 128; u += F.nblk) { const int h = u & 3, qb = u >> 2;
            fa::attn_unit_single<192, 128>(QM + (size_t)qb * 256 * 768 + h * 192, 768, KM + h * 192, 768, VM + h * 128, 512, MIX + (size_t)qb * 256 * D + 1024 + h * 128, D, S, 0.6931471805599453f, lds); }
    }
    float mq = 0.f, mk = 0.f;
    for (int i = 0; i < 64; ++i) { mq = fmaxf(mq, fabsf(gqn[i])); mk = fmaxf(mk, fabsf(gkn[i])); }
    const float bound2 = 8.f * mq * mk * 1.4426950408889634f * 1.02f;
    const bool fixed_ok = bound2 < 80.f;
    const bool bal = F.nblk == 256; const int j = c >> 2;
    const int nw = bal ? (j < 32 ? 1 : 3) : (512 - c + F.nblk - 1) / F.nblk;
    for (int k = 0; k < nw; ++k) {
        const int u = bal ? ((j < 32 ? j : 32 + 3 * (j - 32) + k) * 4 + (c & 3)) : c + k * F.nblk;
        const int kvh = u & 3, w = u >> 2, h = kvh * 4 + (w & 3), qb = w >> 2;
        const bool mlacv = MLAFIX && F.nblk >= 128;
        const int gper = mlacv ? (layer ? CVT_G1 : CVT_G0) : (layer ? CVT_U1 : CVT_U0), gbase = (layer ? CVT_L1 : CVT_EARLY) + (mlacv ? 128 * (layer ? CVT_M1 : CVT_M0) : 0);
        int cv0 = gbase + u * gper, cv1 = cv0 + gper; if (cv1 > CVT_ITEMS) cv1 = CVT_ITEMS; if (cv0 > cv1) cv0 = cv1;
        const int cvper = mlacv ? 3 : (layer ? 3 : 2);
        if (fixed_ok) fa::attn_unit_fixed<64, 64, 2, true>(QG + (size_t)qb * 256 * 1024 + h * 64, 1024, KG + kvh * 64, 256, VG + kvh * 64, 256, MIX + (size_t)qb * 256 * D + h * 64, D, S, lds, a, F.ws, cv0, cv1, cvper);
        else fa::attn_unit<64, 64, 2, true>(QG + (size_t)qb * 256 * 1024 + h * 64, 1024, KG + kvh * 64, 256, VG + kvh * 64, 256, MIX + (size_t)qb * 256 * D + h * 64, D, S, 0.6931471805599453f, lds, a, F.ws, cv0, cv1, cvper); }
}
namespace ml {
using fa::bf16x8; using fa::f32x16; using fa::u32x4; using fa::crow; using fa::cvtpk;
typedef short v4i16_t __attribute__((ext_vector_type(4)));
__device__ __forceinline__ bf16x8 trfrag(const LAS char* p, int d0, int ks) {
    const v4i16_t lo = __builtin_amdgcn_ds_read_tr16_b64_v4i16((LAS v4i16_t*)(p + ((2 * ks) * 4 + d0) * 512));
    const v4i16_t hi = __builtin_amdgcn_ds_read_tr16_b64_v4i16((LAS v4i16_t*)(p + ((2 * ks + 1) * 4 + d0) * 512));
    return (bf16x8){lo[0], lo[1], lo[2], lo[3], hi[0], hi[1], hi[2], hi[3]};
}
__device__ __forceinline__ int img_off(int row, int col) { return (row >> 6) * 16384 + fa::v_st<4>(row & 63, col); }
__device__ __forceinline__ bf16x8 pack8(const float* v) { u32x4 w = {cvtpk(v[0], v[1]), cvtpk(v[2], v[3]), cvtpk(v[4], v[5]), cvtpk(v[6], v[7])}; return __builtin_bit_cast(bf16x8, w); }
__device__ __forceinline__ float hsum2(float v) { auto rr = __builtin_amdgcn_permlane32_swap(__float_as_uint(v), __float_as_uint(v), false, false); return __uint_as_float(rr[0]) + __uint_as_float(rr[1]); }
}

__device__ __forceinline__ void ph_m0_fast(const Frame& F, const float* gb) {
    const float* GT = (const float*)(F.ws + O_GATES); float* GI = (float*)(F.ws + O_GI);
    float* BC = (float*)(F.ws + O_BC); float* WW = (float*)(F.ws + O_WW); float* PM = (float*)(F.ws + O_PM);
    float* GC = (float*)(F.ws + O_CHS); float* MC = GC + 512;
    const int lane = F.lane;
    for (int it = F.gw; it < 512; it += F.ngw) {
        const int dh = it >> 6, cl = it & 63, dir = dh >> 2; const size_t rb = (size_t)dh * S;
        const int tp0 = physt(dir, cl * CH + 2 * lane), tp1 = physt(dir, cl * CH + 2 * lane + 1);
        const int h = dh & 3, ci = (2 * dir) * 4 + h, cf = ci + 4; const float bi = gb[ci], bff = gb[cf];
        const float li0 = GT[(size_t)tp0 * 16 + ci] + bi, li1 = GT[(size_t)tp1 * 16 + ci] + bi;
        const float lf0 = logsigmoidf(GT[(size_t)tp0 * 16 + cf] + bff), lf1 = logsigmoidf(GT[(size_t)tp1 * 16 + cf] + bff);
        GI[rb + tp0] = li0; GI[rb + tp1] = li1;
        float inc = lf0 + lf1;
#pragma unroll
        for (int o = 1; o < 64; o <<= 1) { const float v = __shfl_up(inc, o); if (lane >= o) inc += v; }
        const float b1 = inc, b0 = inc - lf1; const float g = __shfl(inc, 63);
        const float x0 = li0 - b0, x1 = li1 - b1; float mxs = fmaxf(x0, x1);
#pragma unroll
        for (int o = 1; o < 64; o <<= 1) { const float v = __shfl_up(mxs, o); if (lane >= o) mxs = fmaxf(mxs, v); }
        float ex = __shfl_up(mxs, 1); if (lane == 0) ex = -INFINITY;
        const float pm0 = fmaxf(ex, x0), pm1 = fmaxf(pm0, x1);
        const float a0 = g - b0 + li0, a1 = g - b1 + li1; const float ml_ = wave_max(fmaxf(a0, a1));
        BC[rb + tp0] = b0; BC[rb + tp1] = b1; PM[rb + tp0] = pm0; PM[rb + tp1] = pm1; WW[rb + tp0] = expf(a0 - ml_); WW[rb + tp1] = expf(a1 - ml_);
        if (lane == 0) { GC[it] = g; MC[it] = ml_; }
    }
}
__device__ __forceinline__ void ph_m1_fast(const Frame& F) {
    const float* WW = (const float*)(F.ws + O_WW); const bf16* MK = (const bf16*)(F.ws + O_MK); const bf16* MV = (const bf16*)(F.ws + O_MV);
    float* KV = (float*)(F.ws + O_KV); float* KS = (float*)(F.ws + O_KS);
    LAS char* Vimg = (LAS char*)F.lds; LAS char* Kimg = Vimg + 32768;
    const int tid = F.tid, lane = F.lane, r32 = lane & 31, hi = lane >> 5, db = F.wave & 3, eh = F.wave >> 2;
    const int rdb = fa::v_rd_base(lane);
    const ml::bf16x8 ones = {0x3F80, 0x3F80, 0x3F80, 0x3F80, 0x3F80, 0x3F80, 0x3F80, 0x3F80};
    for (int u = F.bid; u < 256; u += F.nblk) {
        const int h = u & 3, co = u >> 2;
#pragma unroll
        for (int p = 0; p < 4; ++p) { const int idx = tid + 512 * p, row = idx >> 4, c8 = idx & 15;
            *(LAS ml::bf16x8*)(Vimg + ml::img_off(row, c8 * 8)) = *(const ml::bf16x8*)(MV + (size_t)(co * CH + row) * 512 + h * 128 + c8 * 8); }
        for (int dir = 0; dir < 2; ++dir) {
            const int dh = dir * 4 + h, cl = dir ? 63 - co : co;
#pragma unroll
            for (int p = 0; p < 4; ++p) { const int idx = tid + 512 * p, row = idx >> 4, c8 = idx & 15; const int tp = co * CH + row;
                const v4u kr = *(const v4u*)(MK + (size_t)tp * 512 + h * 128 + c8 * 8); const float w = WW[(size_t)dh * S + tp];
                float f[8] = {__uint_as_float(kr.x << 16) * w, __uint_as_float(kr.x & 0xffff0000u) * w, __uint_as_float(kr.y << 16) * w, __uint_as_float(kr.y & 0xffff0000u) * w,
                              __uint_as_float(kr.z << 16) * w, __uint_as_float(kr.z & 0xffff0000u) * w, __uint_as_float(kr.w << 16) * w, __uint_as_float(kr.w & 0xffff0000u) * w};
                *(LAS ml::bf16x8*)(Kimg + ml::img_off(row, c8 * 8)) = ml::pack8(f); }
            __syncthreads();
            ml::f32x16 acc0 = {}, acc1 = {}, accs = {};
#pragma unroll
            for (int kk = 0; kk < 8; ++kk) {
                const ml::bf16x8 af = ml::trfrag(Kimg + (kk >> 2) * 16384 + rdb, db, kk & 3);
                const ml::bf16x8 b0 = ml::trfrag(Vimg + (kk >> 2) * 16384 + rdb, 2 * eh, kk & 3), b1 = ml::trfrag(Vimg + (kk >> 2) * 16384 + rdb, 2 * eh + 1, kk & 3);
                acc0 = __builtin_amdgcn_mfma_f32_32x32x16_bf16(af, b0, acc0, 0, 0, 0);
                acc1 = __builtin_amdgcn_mfma_f32_32x32x16_bf16(af, b1, acc1, 0, 0, 0);
                accs = __builtin_amdgcn_mfma_f32_32x32x16_bf16(af, ones, accs, 0, 0, 0);
            }
            float* kvp = KV + ((size_t)(dh * 64 + cl) << 14);
#pragma unroll
            for (int r = 0; r < 16; ++r) { const int d = 32 * db + ml::crow(r, hi);
                kvp[d * 128 + 32 * (2 * eh) + r32] = acc0[r]; kvp[d * 128 + 32 * (2 * eh + 1) + r32] = acc1[r];
                if (eh == 0 && r32 == 0) KS[(size_t)(dh * 64 + cl) * 128 + d] = accs[r]; }
            __syncthreads();
        }
    }
}
__device__ __forceinline__ void ph_m3_fast(const Frame& F, const float* hn) {
    const float* GI = (const float*)(F.ws + O_GI); const float* BC = (const float*)(F.ws + O_BC); const float* PM = (const float*)(F.ws + O_PM);
    const float* MP = (const float*)(F.ws + O_CHS) + 1024; const bf16* MQ = (const bf16*)(F.ws + O_MQ); const bf16* MK = (const bf16*)(F.ws + O_MK); const bf16* MV = (const bf16*)(F.ws + O_MV);
    const float* KV = (const float*)(F.ws + O_KV); const float* KS = (const float*)(F.ws + O_KS); const bf16* RAW = (const bf16*)(F.ws + O_RAW);
    bf16* MIX = (bf16*)(F.ws + O_MIX);
    LAS char* Kimg = (LAS char*)F.lds; LAS char* Vimg = Kimg + 32768; LAS char* Cimg = Kimg + 65536;
    LAS float* bsT = (LAS float*)(Kimg + 98304); LAS float* nT = bsT + 128; LAS float* wsc = nT + 128 + F.wave * 64; LAS float* Hb = (LAS float*)Kimg;
    const int tid = F.tid, lane = F.lane, r32 = lane & 31, hi = lane >> 5, tb = F.wave & 3, eh = F.wave >> 2;
    const int rdb = fa::v_rd_base(lane);
    for (int u = F.bid; u < 256; u += F.nblk) {
        const int h = u & 3, co = u >> 2;
#pragma unroll
        for (int p = 0; p < 4; ++p) { const int idx = tid + 512 * p, row = idx >> 4, c8 = idx & 15; const size_t g = (size_t)(co * CH + row) * 512 + h * 128 + c8 * 8;
            *(LAS ml::bf16x8*)(Kimg + row * 256 + ((c8 * 16) ^ ((row & 7) << 4))) = *(const ml::bf16x8*)(MK + g);
            *(LAS ml::bf16x8*)(Vimg + ml::img_off(row, c8 * 8)) = *(const ml::bf16x8*)(MV + g); }
        const int tl = 32 * tb + r32; const size_t tpt = (size_t)co * CH + tl;
        const bf16* qbase = MQ + tpt * 512 + h * 128 + hi * 8;
        ml::f32x16 hs0 = {}, hs1 = {};
        for (int dir = 0; dir < 2; ++dir) {
            const int dh = dir * 4 + h, cl = dir ? 63 - co : co;
            __syncthreads();
            const float* kvp = KV + ((size_t)(dh * 64 + cl) << 14);
#pragma unroll
            for (int p = 0; p < 4; ++p) { const int idx = tid + 512 * p, row = idx >> 4, c8 = idx & 15;
                const f32x4 c0 = *(const f32x4*)(kvp + row * 128 + c8 * 8), c1 = *(const f32x4*)(kvp + row * 128 + c8 * 8 + 4);
                const float f[8] = {c0.x, c0.y, c0.z, c0.w, c1.x, c1.y, c1.z, c1.w};
                *(LAS ml::bf16x8*)(Cimg + ml::img_off(row, c8 * 8)) = ml::pack8(f); }
            if (tid < 128) { const size_t gi = (size_t)dh * S + (size_t)co * CH + tid; bsT[tid] = (GI[gi] - BC[gi]) * 1.4426950408889634f  ; nT[tid] = KS[(size_t)(dh * 64 + cl) * 128 + tid]; }
            const float Bt = BC[(size_t)dh * S + tpt], mp = MP[dh * 64 + cl], mx = fmaxf(mp, PM[(size_t)dh * S + tpt]);
            const float btl = -mx * 1.4426950408889634f, iw = expf(mp - mx), emt = expf(-(Bt + mx));
            __syncthreads();
            ml::f32x16 o0 = {}, o1 = {}; float dsum = 0.f;
            const int jlo = dir ? (tb >> 1) : 0, jhi = dir ? 1 : (tb >> 1);
            for (int j = jlo; j <= jhi; ++j) {
                ml::f32x16 p0 = {}, p1 = {};
                const LAS char* Kt = Kimg + j * 64 * 256;
                const bf16* qp = qbase; asm volatile("" : "+v"(qp));
                ml::bf16x8 qr[8];
#pragma unroll
                for (int d0 = 0; d0 < 8; ++d0) qr[d0] = *(const ml::bf16x8*)(qp + d0 * 16);
#pragma unroll
                for (int d0 = 0; d0 < 8; ++d0) { const int cb = (d0 * 16 + hi * 8) * 2;
                    const ml::bf16x8 k0 = *(const LAS ml::bf16x8*)(Kt + r32 * 256 + (cb ^ ((r32 & 7) << 4)));
                    const ml::bf16x8 k1 = *(const LAS ml::bf16x8*)(Kt + (32 + r32) * 256 + (cb ^ ((r32 & 7) << 4)));
                    p0 = __builtin_amdgcn_mfma_f32_32x32x16_bf16(k0, qr[d0], p0, 0, 0, 0);
                    p1 = __builtin_amdgcn_mfma_f32_32x32x16_bf16(k1, qr[d0], p1, 0, 0, 0); }
#pragma unroll
                for (int r = 0; r < 16; ++r) { const int s0 = 64 * j + ml::crow(r, hi), s1 = s0 + 32;
                    const float e0 = __builtin_amdgcn_exp2f(btl + bsT[s0]), e1 = __builtin_amdgcn_exp2f(btl + bsT[s1]);
                    const bool v0 = dir ? (s0 >= tl) : (s0 <= tl), v1 = dir ? (s1 >= tl) : (s1 <= tl);
                    p0[r] = v0 ? p0[r] * e0 : 0.f; p1[r] = v1 ? p1[r] * e1 : 0.f; dsum += p0[r] + p1[r]; }
                ml::bf16x8 pa0, pa1, pa2, pa3;
#define ML_PK4(P, BASE, OUT) do { unsigned a0 = ml::cvtpk(P[BASE + 0], P[BASE + 1]), a1 = ml::cvtpk(P[BASE + 2], P[BASE + 3]);   \
    unsigned b0 = ml::cvtpk(P[BASE + 4], P[BASE + 5]), b1 = ml::cvtpk(P[BASE + 6], P[BASE + 7]);                              \
    auto r0 = __builtin_amdgcn_permlane32_swap(a0, b0, false, false); auto r1 = __builtin_amdgcn_permlane32_swap(a1, b1, false, false); \
    ml::u32x4 w = {r0[0], r1[0], r0[1], r1[1]}; OUT = __builtin_bit_cast(ml::bf16x8, w); } while (0)
                ML_PK4(p0, 0, pa0); ML_PK4(p0, 8, pa1); ML_PK4(p1, 0, pa2); ML_PK4(p1, 8, pa3);
#undef ML_PK4
                const LAS char* Vt = Vimg + j * 16384 + rdb;
                o0 = __builtin_amdgcn_mfma_f32_32x32x16_bf16(pa0, ml::trfrag(Vt, 2 * eh, 0), o0, 0, 0, 0); o1 = __builtin_amdgcn_mfma_f32_32x32x16_bf16(pa0, ml::trfrag(Vt, 2 * eh + 1, 0), o1, 0, 0, 0);
                o0 = __builtin_amdgcn_mfma_f32_32x32x16_bf16(pa1, ml::trfrag(Vt, 2 * eh, 1), o0, 0, 0, 0); o1 = __builtin_amdgcn_mfma_f32_32x32x16_bf16(pa1, ml::trfrag(Vt, 2 * eh + 1, 1), o1, 0, 0, 0);
                o0 = __builtin_amdgcn_mfma_f32_32x32x16_bf16(pa2, ml::trfrag(Vt, 2 * eh, 2), o0, 0, 0, 0); o1 = __builtin_amdgcn_mfma_f32_32x32x16_bf16(pa2, ml::trfrag(Vt, 2 * eh + 1, 2), o1, 0, 0, 0);
                o0 = __builtin_amdgcn_mfma_f32_32x32x16_bf16(pa3, ml::trfrag(Vt, 2 * eh, 3), o0, 0, 0, 0); o1 = __builtin_amdgcn_mfma_f32_32x32x16_bf16(pa3, ml::trfrag(Vt, 2 * eh + 1, 3), o1, 0, 0, 0);
            }
            float qn = 0.f;
            const bf16* qp2 = qbase; asm volatile("" : "+v"(qp2));
#pragma unroll
            for (int kk = 0; kk < 8; ++kk) {
                const ml::bf16x8 qv = *(const ml::bf16x8*)(qp2 + kk * 16);
                float f[8];
#pragma unroll
                for (int i = 0; i < 8; ++i) { f[i] = bf2f((bf16)qv[i]); qn += f[i] * nT[16 * kk + 8 * hi + i]; f[i] *= iw; }
                const ml::bf16x8 qs = ml::pack8(f);
                const LAS char* Ct = Cimg + (kk >> 2) * 16384 + rdb;
                o0 = __builtin_amdgcn_mfma_f32_32x32x16_bf16(qs, ml::trfrag(Ct, 2 * eh, kk & 3), o0, 0, 0, 0);
                o1 = __builtin_amdgcn_mfma_f32_32x32x16_bf16(qs, ml::trfrag(Ct, 2 * eh + 1, kk & 3), o1, 0, 0, 0);
            }
            const float den = ml::hsum2(dsum) + iw * ml::hsum2(qn);
            const float rden = 1.f / fmaxf(fabsf(den), emt);
            if (hi == 0) wsc[r32] = rden;
#pragma unroll
            for (int r = 0; r < 16; ++r) { const float rd = wsc[ml::crow(r, hi)]; hs0[r] += o0[r] * rd; hs1[r] += o1[r] * rd; }
        }
        __syncthreads();
#pragma unroll
        for (int r = 0; r < 16; ++r) { const int row = 32 * tb + ml::crow(r, hi); Hb[row * 128 + 32 * (2 * eh) + r32] = hs0[r]; Hb[row * 128 + 32 * (2 * eh + 1) + r32] = hs1[r]; }
        float mo0[16], mo1[16];
#pragma unroll
        for (int i = 0; i < 16; ++i) { const size_t tp = (size_t)co * CH + 16 * F.wave + i; mo0[i] = bf2f(RAW[tp * DINP + C_MO + h * 128 + lane]); mo1[i] = bf2f(RAW[tp * DINP + C_MO + h * 128 + 64 + lane]); }
        const float hn0 = hn[h * 128 + lane], hn1 = hn[h * 128 + 64 + lane];
        __syncthreads();
#pragma unroll
        for (int i = 0; i < 16; ++i) { const int row = 16 * F.wave + i; const size_t tp = (size_t)co * CH + row;
            float v0 = Hb[row * 128 + lane], v1 = Hb[row * 128 + 64 + lane];
            const float mu = wave_sum(v0 + v1) * (1.f / 128.f); v0 -= mu; v1 -= mu;
            const float rstd = 1.f / sqrtf(wave_sum(v0 * v0 + v1 * v1) * (1.f / 128.f) + 1e-5f);
            MIX[tp * D + 1536 + h * 128 + lane] = f2bf(sigmoidf(mo0[i]) * v0 * rstd * hn0);
            MIX[tp * D + 1536 + h * 128 + 64 + lane] = f2bf(sigmoidf(mo1[i]) * v1 * rstd * hn1); }
        __syncthreads();
    }
}
template <int ST>
__device__ __forceinline__ void m2_scan(float* p, const float* GC, const float* MC, float* MP, int dh, bool wm) {
    float C = 0.f, m = 0.f;
    for (int b = 0; b < 2; ++b) {
        float kv[32]; float* pb = p + (size_t)b * 32 * ST;
#pragma unroll
        for (int cl = 0; cl < 32; ++cl) kv[cl] = pb[(size_t)cl * ST];
#pragma unroll
        for (int cl = 0; cl < 32; ++cl) { const float g = GC[dh * 64 + b * 32 + cl], mc = MC[dh * 64 + b * 32 + cl];
            const float mn = fmaxf(g + m, mc), dec = expf(g + m - mn), ad = expf(mc - mn);
            if (wm) MP[dh * 64 + b * 32 + cl] = m;
            const float cin = C; C = dec * C + ad * kv[cl]; kv[cl] = cin; m = mn; }
#pragma unroll
        for (int cl = 0; cl < 32; ++cl) pb[(size_t)cl * ST] = kv[cl];
    }
}
__device__ __forceinline__ void ph_m2(const Frame& F) {
    float* KV = (float*)(F.ws + O_KV); float* KS = (float*)(F.ws + O_KS);
    const float* GC = (const float*)(F.ws + O_CHS); const float* MC = GC + 512; float* MP = (float*)(F.ws + O_CHS) + 1024;
    const int gt = F.bid * NTHR + F.tid, ngt = F.nblk * NTHR;
    for (int it = gt; it < 8 * 16384; it += ngt) { const int dh = (int)(it >> 14), de = (int)(it & 16383); m2_scan<16384>(KV + ((size_t)(dh * 64) << 14) + de, GC, MC, MP, dh, false); }
    for (int it = ngt - 1 - gt; it < 8 * 128; it += ngt) { const int dh = (int)(it >> 7), d = (int)(it & 127); m2_scan<128>(KS + (size_t)dh * 64 * 128 + d, GC, MC, MP, dh, d == 0); }
}
template <int MODE  , bool WRITE_U, bool ROUTE>
__device__ __forceinline__ void ph_ln(const Frame& F, const float* X, const bf16* R  , const float* gate, const float* lg, const float* lb, float* XO,
                                      const float* shift2, const float* scale2, bf16* U, const float* rw) {
    int* TE = (int*)(F.ws + O_TOPK); float* TW = (float*)(F.ws + O_TOPK + 65536); int* TR = (int*)(F.ws + O_TOPK + 131072); const int* SLOT = (const int*)(F.ws + O_TOPK + 196608);
    unsigned* CNT = (unsigned*)(F.ws + O_CTL) + CW_CNT;
    pg8::DownPlan dplan; dplan.T = 0; dplan.tfull = 0; dplan.tt = 0; dplan.f = 1; const bf16* PART = (const bf16*)(F.ws + O_XS);
    if (MODE == 1) { const Seg seg = load_seg(CNT); int ts[9];
#pragma unroll
        for (int i = 0; i < 9; ++i) ts[i] = seg.start[i] >> 8;
        dplan = pg8::down_plan(ts, F.nblk); }
    LAS int* rl = (LAS int*)F.lds; const int NIT = (S + F.ngw - 1) / F.ngw; int kit = 0;
    LAS f32x4* rwl = (LAS f32x4*)(F.lds + 65536);
    LAS f32x4* pl = (LAS f32x4*)(F.lds + 8192);
    for (int q = F.tid; q < 512; q += NTHR) { pl[q] = *(const f32x4*)(gate + 4 * q); pl[512 + q] = *(const f32x4*)(lg + 4 * q); pl[1024 + q] = *(const f32x4*)(lb + 4 * q);
        if (WRITE_U) { pl[1536 + q] = *(const f32x4*)(scale2 + 4 * q); pl[2048 + q] = *(const f32x4*)(shift2 + 4 * q); } }
    if (!ROUTE) __syncthreads();
    if (ROUTE) { for (int i = F.tid; i < NWAVES * NIT * 2; i += NTHR) rl[i] = -1;
        for (int q = F.tid; q < 4096; q += NTHR) { const int ln = q & 63, hf = (q >> 6) & 1, c = (q >> 7) & 3, i = q >> 9; rwl[q] = *(const f32x4*)(rw + (size_t)(4 * ln + 256 * i + c) * 8 + 4 * hf); }
        __syncthreads(); }
    int s0n = 0, s1n = 0; float w0n = 0.f, w1n = 0.f;
    if (MODE == 1) { const int tp = F.gw < S ? F.gw : S - 1; s0n = SLOT[2 * tp]; s1n = SLOT[2 * tp + 1]; w0n = TW[2 * tp]; w1n = TW[2 * tp + 1]; }
    for (int t = F.gw; t < S; t += F.ngw) {
        int j0 = 4 * F.lane; asm volatile("" : "+v"(j0));
        float y[32]; float s = 0.f;
        const bf16* r0 = R + (size_t)t * D; const bf16* r1 = r0; const bf16* q0 = PART; const bf16* q1 = PART; float w0 = 1.f, w1 = 0.f; int n0 = 1, n1 = 1;
        if (MODE == 1) { const int s0 = s0n, s1 = s1n; w0 = w0n; w1 = w1n;
            { const int tn = t + F.ngw < S ? t + F.ngw : t; s0n = SLOT[2 * tn]; s1n = SLOT[2 * tn + 1]; w0n = TW[2 * tn]; w1n = TW[2 * tn + 1]; }
            if (dplan.f > 1 && (s0 >> 8) >= dplan.tfull) { q0 = PART + ((size_t)(((s0 >> 8) - dplan.tfull) * dplan.f) * 256 + (s0 & 255)) * D; n0 = dplan.f; } else r0 = R + (size_t)s0 * D;
            if (dplan.f > 1 && (s1 >> 8) >= dplan.tfull) { q1 = PART + ((size_t)(((s1 >> 8) - dplan.tfull) * dplan.f) * 256 + (s1 & 255)) * D; n1 = dplan.f; } else r1 = R + (size_t)s1 * D; }
#pragma unroll
        for (int i = 0; i < 8; ++i) { const int j = j0 + 256 * i; const f32x4 x = __builtin_nontemporal_load((const f32x4*)(X + (size_t)t * D + j)), g = pl[(j0 >> 2) + 64 * i];
            f32x4 r;
            if (MODE != 1 || n0 == 1) r = ld4bf(r0 + j); else { r = ld4bf(q0 + j); for (int q = 1; q < n0; ++q) r += ld4bf(q0 + (size_t)q * 256 * D + j); }
            if (MODE == 1) { f32x4 rb; if (n1 == 1) rb = ld4bf(r1 + j); else { rb = ld4bf(q1 + j); for (int q = 1; q < n1; ++q) rb += ld4bf(q1 + (size_t)q * 256 * D + j); }
                r = r * w0 + rb * w1; }
            y[4 * i + 0] = ALPHA * x.x + g.x * r.x; y[4 * i + 1] = ALPHA * x.y + g.y * r.y; y[4 * i + 2] = ALPHA * x.z + g.z * r.z; y[4 * i + 3] = ALPHA * x.w + g.w * r.w;
            s += (y[4 * i] + y[4 * i + 1]) + (y[4 * i + 2] + y[4 * i + 3]); }
        const float mu = wave_sum(s) * (1.f / D); float q = 0.f;
#pragma unroll
        for (int i = 0; i < 32; ++i) { y[i] -= mu; q += y[i] * y[i]; }
        const float rstd = 1.f / sqrtf(wave_sum(q) * (1.f / D) + 1e-5f);
        float lg8[8];
#pragma unroll
        for (int e = 0; e < 8; ++e) lg8[e] = 0.f;
#pragma unroll
        for (int i = 0; i < 8; ++i) { const int j = j0 + 256 * i; const f32x4 g = pl[512 + (j0 >> 2) + 64 * i], b = pl[1024 + (j0 >> 2) + 64 * i];
            f32x4 o = {y[4 * i] * rstd * g.x + b.x, y[4 * i + 1] * rstd * g.y + b.y, y[4 * i + 2] * rstd * g.z + b.z, y[4 * i + 3] * rstd * g.w + b.w};
            __builtin_nontemporal_store(o, (f32x4*)(XO + (size_t)t * D + j));
            if (WRITE_U) { const f32x4 sc = pl[1536 + (j0 >> 2) + 64 * i], sh = pl[2048 + (j0 >> 2) + 64 * i];
                const f32x4 u = {o.x * (1.f + sc.x) + sh.x, o.y * (1.f + sc.y) + sh.y, o.z * (1.f + sc.z) + sh.z, o.w * (1.f + sc.w) + sh.w};
                v2u w; w.x = (unsigned)f2bf(u.x) | ((unsigned)f2bf(u.y) << 16); w.y = (unsigned)f2bf(u.z) | ((unsigned)f2bf(u.w) << 16);
                *(v2u*)(U + (size_t)t * D + j) = w;
                if (ROUTE) {
#pragma unroll
                    for (int c = 0; c < 4; ++c) { const float uv = c == 0 ? u.x : c == 1 ? u.y : c == 2 ? u.z : u.w; const f32x4 ra = rwl[((i * 4 + c) * 2 + 0) * 64 + F.lane], rb = rwl[((i * 4 + c) * 2 + 1) * 64 + F.lane];
                        lg8[0] += uv * ra.x; lg8[1] += uv * ra.y; lg8[2] += uv * ra.z; lg8[3] += uv * ra.w; lg8[4] += uv * rb.x; lg8[5] += uv * rb.y; lg8[6] += uv * rb.z; lg8[7] += uv * rb.w; } } }
        }
        if (ROUTE) {
#pragma unroll
            for (int e = 0; e < 8; ++e) lg8[e] = wave_sum(lg8[e]);
            int i0 = 0; float v0 = lg8[0];
#pragma unroll
            for (int e = 1; e < 8; ++e) if (lg8[e] > v0) { v0 = lg8[e]; i0 = e; }
            int i1 = -1; float v1 = -INFINITY;
#pragma unroll
            for (int e = 0; e < 8; ++e) if (e != i0 && lg8[e] > v1) { v1 = lg8[e]; i1 = e; }
            if (F.lane == 0) { const float p0 = 1.f / (1.f + expf(v1 - v0)); TE[2 * t] = i0; TE[2 * t + 1] = i1; TW[2 * t] = p0; TW[2 * t + 1] = 1.f - p0;
                rl[(F.wave * NIT + kit) * 2] = i0; rl[(F.wave * NIT + kit) * 2 + 1] = i1; }
            ++kit;
        }
    }
    if (ROUTE) {
        __syncthreads();
        const int n = NWAVES * NIT * 2;
        for (int i = F.tid; i < n; i += NTHR) { const int e = rl[i];
            if (e >= 0) { int r = 0; for (int q = 0; q < i; ++q) r += (rl[q] == e) ? 1 : 0;
                const int w = i / (2 * NIT), k = (i >> 1) % NIT, t = F.bid * NWAVES + w + k * F.ngw; TR[2 * t + (i & 1)] = r; } }
        if (F.tid < 8) { int cnt = 0; for (int q = 0; q < n; ++q) cnt += (rl[q] == F.tid) ? 1 : 0; ((int*)(F.ws + O_BCNT))[F.bid * 8 + F.tid] = cnt; }
        __syncthreads();
    }
}
__device__ __forceinline__ void ph_gather(const Frame& F) {
    const int* TE = (const int*)(F.ws + O_TOPK); const int* TR = (const int*)(F.ws + O_TOPK + 131072); int* SLOT = (int*)(F.ws + O_TOPK + 196608);
    LAS int* sh = (LAS int*)F.lds; const int* BCNT = (const int*)(F.ws + O_BCNT);
    if (F.tid < 16) sh[F.tid] = 0;
    __syncthreads();
    for (int i = F.tid; i < F.nblk * 8; i += NTHR) { const int v = BCNT[i], b = i >> 3, e = i & 7; atomicAdd((int*)(sh + 8 + e), v); if (b < F.bid) atomicAdd((int*)(sh + e), v); }
    __syncthreads();
    int base[8]; unsigned tot[8];
#pragma unroll
    for (int e = 0; e < 8; ++e) { base[e] = __builtin_amdgcn_readfirstlane(sh[e]); tot[e] = (unsigned)__builtin_amdgcn_readfirstlane(sh[8 + e]); }
    if (F.bid == 0 && F.tid < 8) ((unsigned*)(F.ws + O_CTL) + CW_CNT)[F.tid] = (unsigned)sh[8 + F.tid];
    Seg seg; { int acc = 0;
#pragma unroll
        for (int e = 0; e < 8; ++e) { seg.start[e] = acc; acc += ((int)tot[e] + 255) & ~255; }
        seg.start[8] = acc; }
    __syncthreads();
    const bf16* U = (const bf16*)(F.ws + O_U); bf16* XS = (bf16*)(F.ws + O_XS);
    for (int t = F.gw; t < S; t += F.ngw) {
        v4u r[4];
#pragma unroll
        for (int i = 0; i < 4; ++i) r[i] = *(const v4u*)(U + (size_t)t * D + 8 * F.lane + 512 * i);
#pragma unroll
        for (int k = 0; k < 2; ++k) { const int e = TE[2 * t + k]; int slot = 0;
#pragma unroll
            for (int i = 0; i < 8; ++i) if (i == e) slot = seg.start[i] + base[i];
            slot += TR[2 * t + k]; if (F.lane == 0) SLOT[2 * t + k] = slot;
#pragma unroll
            for (int i = 0; i < 4; ++i) *(v4u*)(XS + (size_t)slot * D + 8 * F.lane + 512 * i) = r[i]; }
    }
}

constexpr int LDS_BYTES = 147456, LDSCTL_OFF = 131072;
constexpr int NPH_LAYER = 12, NPH = 1 + 2 * NPH_LAYER;
#ifndef N_LAUNCH_MODE
#define N_LAUNCH_MODE 1
#endif
__device__ __forceinline__ unsigned char* opq(unsigned char* p) { asm volatile("" : "+s"(p)); return p; }
#define IN(k) (lo <= (k) && (k) < hi)
#define SEAM(k, kn) do { if (IN(k) && IN(kn)) xcd_barrier(bar); } while (0)
#ifndef PROBE_MASK
#define PROBE_MASK 0u
#endif
#define PHASE(k) if (IN(k)) for (int rep_ = 0; rep_ < ((((PROBE_MASK) >> (k)) & 1u) ? 2 : 1); ++rep_) for (Frame G = F, *once_ = &G; once_; once_ = nullptr) if ((G.ws = opq(F.ws)), (rep_ ? __syncthreads() : (void)0), true)
template <int L>
__device__ __forceinline__ void run_layer(const Frame& F, const Args& a, const int lo, const int hi, const XcdBarrier& bar) {
    constexpr int P = 1 + L * NPH_LAYER; constexpr int l = L;
    if (L == 0) PHASE(P + 0) { const float* md = (const float*)(G.ws + O_MOD) + L * NMOD; ph_modulate(G, L ? (const float*)(G.ws + O_XB) : a.in[0], md, md + D, (bf16*)(G.ws + O_U)); }
    if (L == 0) SEAM(P + 0, P + 1);
    PHASE(P + 1) { fgemm(G, (const bf16*)(G.ws + O_U), (const bf16*)(G.ws + O_WIN) + (size_t)L * DINP * D, S, DINP, D, pg8::EpiBf16Gate{(bf16*)(G.ws + O_RAW), DINP, (float*)(G.ws + O_GATES), C_MG}); }
    SEAM(P + 1, P + 2);
    PHASE(P + 2) { ph_post(G, a, l); ph_m0_fast(G, LIN(10)); }
    SEAM(P + 2, P + 3);
    PHASE(P + 3) { fgemm(G, (const bf16*)(G.ws + O_CQ), (const bf16*)(G.ws + O_WUQ) + (size_t)L * 768 * 512, S, 768, 512, pg8::EpiBf16{(bf16*)(G.ws + O_RAWQ), 768});
                   fgemm(G, (const bf16*)(G.ws + O_CKV), (const bf16*)(G.ws + O_WUKV) + (size_t)L * 1024 * 256, S, 1024, 256, pg8::EpiBf16{(bf16*)(G.ws + O_RAWKV), 1024}, G.nblk / 2);
                   ph_m1_fast(G); }
    SEAM(P + 3, P + 4);
    PHASE(P + 4) { ph_mlapost(G, L); ph_m2(G); }
    SEAM(P + 4, P + 5);
    PHASE(P + 5) { if (mla_bounds_ok(G)) ph_fattn<true>(G, a, L, LIN(3), LIN(4)); else ph_fattn<false>(G, a, L, LIN(3), LIN(4)); ph_m3_fast(G, LIN(11)); }
    SEAM(P + 5, P + 6);
    PHASE(P + 6) { fgemm(G, (const bf16*)(G.ws + O_MIX), (const bf16*)(G.ws + O_WOUT) + (size_t)L * D * D, S, D, D, pg8::EpiBf16{(bf16*)(G.ws + O_RAW), D}); }
    SEAM(P + 6, P + 7);
    PHASE(P + 7) { const float* md = (const float*)(G.ws + O_MOD) + L * NMOD; const float* Xin = L ? (const float*)(G.ws + O_XB) : a.in[0];
                   ph_ln<0, true, L == 1>(G, Xin, (const bf16*)(G.ws + O_RAW), md + 2 * D, LIN(13), LIN(14), (float*)(G.ws + O_XA), md + 3 * D, md + 4 * D, (bf16*)(G.ws + O_U), L ? a.in[37] : nullptr); }
    SEAM(P + 7, P + 8);
    if (L == 0) {
        PHASE(P + 8) { fgemm(G, (const bf16*)(G.ws + O_U), (const bf16*)(G.ws + O_WGU0), S, 2 * FF0, D, pg8::EpiSwiglu{(bf16*)(G.ws + O_H), FF0}); }
        SEAM(P + 8, P + 9);
        PHASE(P + 9) { fgemm(G, (const bf16*)(G.ws + O_H), (const bf16*)(G.ws + O_WD0), S, D, FF0, pg8::EpiBf16{(bf16*)(G.ws + O_RAW + 64 * MiB), D}); }
        SEAM(P + 9, P + 11);
        PHASE(P + 11) { const float* md = (const float*)(G.ws + O_MOD) + L * NMOD;
                        ph_ln<0, true, false>(G, (const float*)(G.ws + O_XA), (const bf16*)(G.ws + O_RAW + 64 * MiB), md + 5 * D, a.in[20], a.in[21], (float*)(G.ws + O_XB), md + NMOD, md + NMOD + D, (bf16*)(G.ws + O_U), nullptr); }
    } else {
        PHASE(P + 8) { ph_gather(G); }
        SEAM(P + 8, P + 9);
        PHASE(P + 9) { const Seg seg = load_seg((const unsigned*)(G.ws + O_CTL) + CW_CNT);
                        fgemm_grouped(G, (const bf16*)(G.ws + O_XS), (const bf16*)(G.ws + O_WGU1), 2 * FF1, D, (size_t)2 * FF1 * D * 2, seg, pg8::EpiSwiglu{(bf16*)(G.ws + O_H), FF1}); }
        SEAM(P + 9, P + 10);
        PHASE(P + 10) { const Seg seg = load_seg((const unsigned*)(G.ws + O_CTL) + CW_CNT);
                        pg8::DownOrder So; So.G = G.nblk; So.c = G.bid;
#pragma unroll
                        for (int i = 0; i < 9; ++i) So.tstart[i] = seg.start[i] >> 8;
                        So.p = pg8::down_plan(So.tstart, G.nblk);
                        { So.tail = false; pg8::Gemm g{(const bf16*)(G.ws + O_H), (const bf16*)(G.ws + O_WD1), MPAD, D, FF1, (size_t)D * FF1 * 2, FF1};
                          pg8::gemm_phase<pg8::EpiBf16, pg8::DownOrder, true, true>(G.lds, g, So, pg8::EpiBf16{(bf16*)(G.ws + O_RAW), D}); }
                        if (So.p.f > 1) { So.tail = true; pg8::Gemm g{(const bf16*)(G.ws + O_H), (const bf16*)(G.ws + O_WD1), MPAD, D, FF1 / So.p.f, (size_t)D * FF1 * 2, FF1};
                          pg8::gemm_phase<pg8::EpiBf16Part, pg8::DownOrder, true, true>(G.lds, g, So, pg8::EpiBf16Part{(pg8::bf16_t*)(G.ws + O_XS), D, So.p.tfull, So.p.f}); } }
        SEAM(P + 10, P + 11);
        PHASE(P + 11) { const float* md = (const float*)(G.ws + O_MOD) + L * NMOD;
                        ph_ln<1, false, false>(G, (const float*)(G.ws + O_XA), (const bf16*)(G.ws + O_RAW), md + 5 * D, a.in[41], a.in[42], a.out, nullptr, nullptr, nullptr, nullptr); }
    }
}
__global__ void __launch_bounds__(NTHR, 2) fwd(Args a) {
    extern __shared__ __attribute__((aligned(16))) unsigned char lds_raw[];
    Frame F;
    F.lds = (LAS unsigned char*)lds_raw; F.ws = a.ws;
    F.tid = threadIdx.x; F.lane = F.tid & 63; F.wave = __builtin_amdgcn_readfirstlane(F.tid >> 6);
    F.bid = blockIdx.x; F.nblk = gridDim.x; F.gw = F.bid * NWAVES + F.wave; F.ngw = F.nblk * NWAVES;
    const int lo = a.ph_lo, hi = a.ph_hi;
    if (F.tid < 64) ((LAS unsigned*)(F.lds + LDSCTL_OFF))[F.tid] = 0u;
    __syncthreads();
    XcdBarrier bar; bar.bar = (unsigned*)(a.ws + O_CTL) + CW_BAR; bar.x = 0; bar.st = nullptr;
    if (hi - lo > 1) bar = xcd_barrier_post((unsigned*)(a.ws + O_CTL) + CW_BAR, (volatile LAS unsigned*)(F.lds + LDSCTL_OFF + 32));
    PHASE(0) { ph_mod_fast(G, a); ph_rope_table(G); ph_convert(G, a, 0, CVT_EARLY); }
    SEAM(0, 1);
    run_layer<0>(F, a, lo, hi, bar);
    SEAM(1 + 11, 1 + NPH_LAYER + 1);
    run_layer<1>(F, a, lo, hi, bar);
}

extern "C" void kernel_launch(void* const* d_in, const int* in_sizes, int n_in, void* d_out, int out_size, void* d_ws, size_t ws_size, hipStream_t stream) {
    static int grid = 0;
    if (grid == 0) {
        if (n_in != 43 || out_size != S * D || ws_size < O_END) { fprintf(stderr, "kernel_launch: unexpected shapes: n_in %d out %d ws %zu (need %zu)\n", n_in, out_size, ws_size, (size_t)O_END); grid = -1; return; }
        int dev = 0, cus = 0;
        if (hipGetDevice(&dev) != hipSuccess || hipDeviceGetAttribute(&cus, hipDeviceAttributeMultiprocessorCount, dev) != hipSuccess) { grid = -1; return; }
        if (hipFuncSetAttribute((const void*)fwd, hipFuncAttributeMaxDynamicSharedMemorySize, LDS_BYTES) != hipSuccess) { fprintf(stderr, "kernel_launch: hipFuncSetAttribute failed\n"); grid = -1; return; }
        int per_cu = 0; (void)hipOccupancyMaxActiveBlocksPerMultiprocessor(&per_cu, (const void*)fwd, NTHR, LDS_BYTES); (void)hipGetLastError();
        if (per_cu < 1) fprintf(stderr, "kernel_launch: occupancy query reports %d workgroups per CU\n", per_cu);
        grid = cus;
    }
    if (grid < 0) return;
    (void)hipMemsetAsync((char*)d_ws + O_CTL, 0, MiB, stream);
    Args a{};
    for (int i = 0; i < 43; ++i) a.in[i] = (const float*)d_in[i];
    a.out = (float*)d_out; a.ws = (unsigned char*)d_ws;
#if N_LAUNCH_MODE == 1
    a.ph_lo = 0; a.ph_hi = NPH;
    hipLaunchKernelGGL(fwd, dim3(grid), dim3(NTHR), LDS_BYTES, stream, a);
#else
    for (int ph = 0; ph < NPH; ++ph) {
        if (ph == 1 + 10 || ph == 1 + NPH_LAYER) continue;
        a.ph_lo = ph; a.ph_hi = ph + 1;
        hipLaunchKernelGGL(fwd, dim3(grid), dim3(NTHR), LDS_BYTES, stream, a);
    }
#endif
}
```

```cpp
#include <hip/hip_runtime.h>
#include <cstdio>
#include <cstdint>
#include <cmath>

#define LAS __attribute__((address_space(3)))
#define GAS __attribute__((address_space(1)))
typedef unsigned short bf16;
typedef unsigned v4u __attribute__((ext_vector_type(4)));
typedef unsigned v2u __attribute__((ext_vector_type(2)));
typedef float f32x4 __attribute__((ext_vector_type(4)));

constexpr int S = 8192, D = 2048, DIN = 4432, DINP = 4608;
constexpr int NMOD = 6 * D;
constexpr int FF0 = 5632, FF1 = 7168, NEXP = 8;
constexpr int MPAD = 18432;
constexpr int NCH = 64, CH = 128, MH = 4, MD = 128;
constexpr float ALPHA = 1.4142135623730951f;
constexpr int NWAVES = 8, NTHR = 512;
constexpr float MLA_QSCALE = 0.07216878364870323f * 1.4426950408889634f;
constexpr float GQA_QSCALE = 0.125f * 1.4426950408889634f;

constexpr int C_GQ = 0, C_GK = 1024, C_GV = 1280, C_CQ = 1536, C_CKV = 2048, C_KR = 2304, C_MQ = 2368, C_MK = 2880, C_MV = 3392, C_MO = 3904, C_MG = 4416;

constexpr size_t MiB = 1u << 20;
constexpr size_t O_CTL = 0;
constexpr size_t O_MOD = O_CTL + MiB;
constexpr size_t O_GI = O_MOD + MiB;
constexpr size_t O_LF = O_GI + MiB;
constexpr size_t O_GATES = O_LF;
constexpr size_t O_BC = O_LF + MiB;
constexpr size_t O_WW = O_BC + MiB;
constexpr size_t O_PM = O_WW + MiB;
constexpr size_t O_KS = O_PM + MiB;
constexpr size_t O_CHS = O_KS + MiB;
constexpr size_t O_BCNT = O_CHS + 256 * 1024;
constexpr size_t O_MLAB = O_CHS + 512 * 1024;
constexpr size_t O_TOPK = O_CHS + MiB;
constexpr size_t O_U = O_TOPK + MiB;
constexpr size_t O_XA = O_U + 32 * MiB;
constexpr size_t O_XB = O_XA + 64 * MiB;
constexpr size_t O_MIX = O_XB + 64 * MiB;
constexpr size_t O_QG = O_MIX + 32 * MiB;
constexpr size_t O_KG = O_QG + 16 * MiB;
constexpr size_t O_VG = O_KG + 4 * MiB;
constexpr size_t O_CQ = O_VG + 4 * MiB;
constexpr size_t O_CKV = O_CQ + 8 * MiB;
constexpr size_t O_QM = O_CKV + 4 * MiB;
constexpr size_t O_KM = O_QM + 12 * MiB;
constexpr size_t O_VM = O_KM + 12 * MiB;
constexpr size_t O_MQ = O_VM + 8 * MiB;
constexpr size_t O_MK = O_MQ + 8 * MiB;
constexpr size_t O_MV = O_MK + 8 * MiB;
constexpr size_t O_RAWQ = O_MV + 8 * MiB;
constexpr size_t O_RAWKV = O_RAWQ + 24 * MiB;
constexpr size_t O_KV = O_RAWKV + 32 * MiB;
constexpr size_t O_RAW = O_KV + 32 * MiB;
constexpr size_t O_H = O_RAW + 144 * MiB;
constexpr size_t O_XS = O_H + 252 * MiB;
constexpr size_t O_WIN = O_XS + 72 * MiB;
constexpr size_t O_WUQ = O_WIN + 36 * MiB;
constexpr size_t O_WUKV = O_WUQ + 2 * MiB;
constexpr size_t O_WOUT = O_WUKV + 2 * MiB;
constexpr size_t O_WGU0 = O_WOUT + 16 * MiB;
constexpr size_t O_WD0 = O_WGU0 + 44 * MiB;
constexpr size_t O_WGU1 = O_WD0 + 22 * MiB;
constexpr size_t O_WD1 = O_WGU1 + 448 * MiB;
constexpr size_t O_ROPE = O_WD1 + 224 * MiB;
constexpr size_t O_END = O_ROPE + 2 * MiB;
constexpr int CW_CNT = 64;
constexpr int CW_BAR = 4096;

__device__ __forceinline__ float bf2f(bf16 v) { return __uint_as_float((unsigned)v << 16); }
__device__ __forceinline__ bf16 f2bf(float f) { unsigned u = __float_as_uint(f); return (bf16)((u + 0x7fffu + ((u >> 16) & 1u)) >> 16); }
__device__ __forceinline__ float wave_sum(float v) {
#pragma unroll
    for (int o = 1; o < 64; o <<= 1) v += __shfl_xor(v, o);
    return v;
}
__device__ __forceinline__ float wave_max(float v) {
#pragma unroll
    for (int o = 1; o < 64; o <<= 1) v = fmaxf(v, __shfl_xor(v, o));
    return v;
}
__device__ __forceinline__ float siluf(float v) { return v / (1.f + expf(-v)); }
__device__ __forceinline__ float sigmoidf(float v) { return 1.f / (1.f + expf(-v)); }
__device__ __forceinline__ float logsigmoidf(float x) { return x >= 0.f ? -log1pf(expf(-x)) : x - log1pf(expf(x)); }
__device__ __forceinline__ int physt(int dir, int tl) { return dir ? (S - 1 - tl) : tl; }
__device__ __forceinline__ int opq_tid() { int t = threadIdx.x; asm volatile("" : "+v"(t)); return t; }

struct Args { const float* in[43]; float* out; unsigned char* ws; int ph_lo, ph_hi; };
#define LIN(k) (l ? a.in[22 + (k)] : a.in[2 + (k)])

struct Frame {
    LAS unsigned char* lds;
    unsigned char* ws;
    int tid, lane, wave, bid, nblk;
    int gw, ngw;
};

struct Seg { int start[9]; };
__device__ __forceinline__ Seg load_seg(const unsigned* cnt) {
    Seg s; int acc = 0;
#pragma unroll
    for (int e = 0; e < 8; ++e) { s.start[e] = acc; acc += (__builtin_amdgcn_readfirstlane((int)cnt[e]) + 255) & ~255; }
    s.start[8] = acc; return s;
}
__device__ __forceinline__ int seg_expert(const Seg& s, int row) {
    int e = -1;
#pragma unroll
    for (int i = 0; i < 8; ++i) if (row >= s.start[i] && row < s.start[i + 1]) e = i;
    return e;
}
#define XB_TMO      128
#define XB_XCNT(j)  (256  + 64 * (j))
#define XB_XSUB(j)  (1280 + 64 * (j))
#define XB_XGEN(j)  (2304 + 64 * (j))
#define XB_TOP      3328
#define XB_TOPGEN   3392
#define XCD_BAR_WORDS 3456
#define XB_SPIN_CAP (1u << 18)

__device__ __forceinline__ unsigned xb_ld(unsigned* p)              { return __hip_atomic_load(p, __ATOMIC_RELAXED, __HIP_MEMORY_SCOPE_AGENT); }
__device__ __forceinline__ unsigned xb_add(unsigned* p, unsigned v) { return __hip_atomic_fetch_add(p, v, __ATOMIC_RELAXED, __HIP_MEMORY_SCOPE_AGENT); }
__device__ __forceinline__ unsigned xb_xcc_id() { return (unsigned)__builtin_amdgcn_s_getreg((3 << 11) | 20) & 0xFu; }
#define XB_SPIN(cond, bar) do { unsigned _sp = 0; while (cond) { __builtin_amdgcn_s_sleep(1); \
    if ((++_sp & 255u) == 0u) { if (xb_ld(&(bar)[XB_TMO])) break; if (_sp > XB_SPIN_CAP) { atomicAdd(&(bar)[XB_TMO], 1u); break; } } } } while (0)

struct XcdBarrier {
    unsigned* bar; unsigned x;
    volatile LAS unsigned* st;
};

__device__ __forceinline__ XcdBarrier xcd_barrier_post(unsigned* bar, volatile LAS unsigned* st) {
    XcdBarrier b; b.bar = bar; b.x = xb_xcc_id(); b.st = st;
    if (threadIdx.x == 0) (void)xb_add(&bar[XB_XCNT(b.x)], 1u);
    return b;
}
__device__ __forceinline__ void xcd_barrier_complete(unsigned* bar, unsigned x, unsigned& nloc, unsigned& nx) {
    const unsigned G = gridDim.x * gridDim.y * gridDim.z;
    unsigned sum, cnt, mine, sp = 0u;
    for (;;) {
        sum = 0u; cnt = 0u; mine = 0u;
#pragma unroll
        for (unsigned j = 0; j < 16; ++j) { const unsigned c = xb_ld(&bar[XB_XCNT(j)]); sum += c; cnt += (c > 0u) ? 1u : 0u; mine = (j == x) ? c : mine; }
        if (sum == G) break;
        __builtin_amdgcn_s_sleep(1);
        if ((++sp & 255u) == 0u) { if (xb_ld(&bar[XB_TMO])) break; if (sp > XB_SPIN_CAP) { atomicAdd(&bar[XB_TMO], 1u); break; } }
    }
    nloc = mine > 0u ? mine : 1u; nx = cnt > 0u ? cnt : 1u;
}

__device__ __forceinline__ void xcd_barrier(const XcdBarrier& b) {
    asm volatile("s_waitcnt vmcnt(0)" ::: "memory");
    __syncthreads();
    if (threadIdx.x == 0) {
        unsigned* bar = b.bar;
        __builtin_amdgcn_s_waitcnt(0);
        unsigned nloc = b.st[0], nx = b.st[1];
        if (nloc == 0u) { xcd_barrier_complete(bar, b.x, nloc, nx); b.st[0] = nloc; b.st[1] = nx; }
        const unsigned old = xb_add(&bar[XB_XSUB(b.x)], 1u);
        const unsigned gen = old / nloc;
        if (old + 1u == (gen + 1u) * nloc) {
            __builtin_amdgcn_fence(__ATOMIC_RELEASE, "agent");
            asm volatile("s_waitcnt vmcnt(0)" ::: "memory");
            const unsigned og = xb_add(&bar[XB_TOP], 1u);
            const unsigned tg = og / nx;
            if (og + 1u == (tg + 1u) * nx) xb_add(&bar[XB_TOPGEN], 1u);
            else XB_SPIN(xb_ld(&bar[XB_TOPGEN]) == tg, bar);
            __builtin_amdgcn_fence(__ATOMIC_ACQUIRE, "agent");
            xb_add(&bar[XB_XGEN(b.x)], 1u);
            asm volatile("s_waitcnt vmcnt(0)" ::: "memory");
        } else {
            XB_SPIN(xb_ld(&bar[XB_XGEN(b.x)]) == gen, bar);
            __builtin_amdgcn_fence(__ATOMIC_ACQUIRE, "agent");
            asm volatile("s_waitcnt vmcnt(0)" ::: "memory");
        }
    }
    __syncthreads();
}

namespace pg8 {
#define PG8_LAS __attribute__((address_space(3)))
typedef unsigned short bf16_t;
typedef short bf16x8 __attribute__((ext_vector_type(8)));
typedef float f32x4 __attribute__((ext_vector_type(4)));
typedef unsigned u32x4 __attribute__((ext_vector_type(4)));
constexpr int BM = 256, BK = 64, HALF = 128, HTB = HALF * BK * 2  , STAGE_BYTES = 8 * HTB, NXCD = 8, WGM = 8;

__host__ __device__ __forceinline__ int lds_byte(int r, int c) { const int st = (r >> 4) * 2 + (c >> 5), rr = r & 15, cc = c & 31, ob = rr * 64 + cc * 2; return st * 1024 + (ob ^ (((ob >> 9) & 1) << 5)); }
__host__ __device__ __forceinline__ void stage_rc(int b, int& R, int& C) { const int st = b / 1024, sb = b % 1024, swz = sb ^ (((sb >> 9) & 1) << 5); R = (st >> 1) * 16 + swz / 64; C = (st & 1) * 32 + (swz % 64) / 2; }
__host__ __device__ __forceinline__ int perm32(int rho) { const int n = rho >> 4, i = rho & 15; return 8 * (i >> 2) + 4 * n + (i & 3); }

struct Unit { int pm, pn, e, ks; };
struct Gemm { const bf16_t* A; const bf16_t* Bt; int M, N, K; size_t gbytes; int ldk; };

struct StaticOrder {
    int nM, nN, nwg, G, c;
    __host__ __device__ void init(int M, int N, int G_, int c_) { nM = M / BM; nN = N / BM; nwg = nM * nN; G = G_; c = c_; }
    __host__ __device__ bool next(int i, Unit& u) const {
        const long L = (long)i * G + c; if (L >= nwg) return false;
        int wgid = (int)L; { const int q = nwg / NXCD, r = nwg % NXCD, xcd = wgid % NXCD, off = wgid / NXCD; wgid = (xcd < r ? xcd * (q + 1) : r * (q + 1) + (xcd - r) * q) + off; }
        const int nig = WGM * nN, gid = wgid / nig, fm = gid * WGM, gsz = (nM - fm) < WGM ? (nM - fm) : WGM;
        u.pm = fm + ((wgid % nig) % gsz); u.pn = (wgid % nig) / gsz; u.e = 0; u.ks = 0; return true;
    }
    __device__ __forceinline__ void a_ready(const Unit&) const {}
    __device__ __forceinline__ void done(const Unit&) const {}
};


struct GroupedOrder {
    int nN, G, c; int tstart[9];
    __device__ __forceinline__ bool next(int i, Unit& u) const {
        int L = i * G + c; if (L >= tstart[8] * nN) return false;
        int es = -1, ts = 0, te = 1;
#pragma unroll
        for (int e = 0; e < 8; ++e) { const int t = tstart[e + 1] - tstart[e], ue = t * nN; if (es < 0) { if (L < ue) { es = e; ts = tstart[e]; te = t; } else L -= ue; } }
        u.e = es; u.pm = ts + L / nN; u.pn = L % nN; u.ks = 0; return true;
    }
    __device__ __forceinline__ void a_ready(const Unit&) const {}
    __device__ __forceinline__ void done(const Unit&) const {}
};
struct DownPlan { int T, tfull, tt, f; };
__device__ __forceinline__ DownPlan down_plan(const int (&tstart)[9], int G) {
    DownPlan p; p.T = tstart[8]; const int U = p.T * 8, R = U / G; int r = U - R * G;
    p.f = 1; if (r > 0 && (G % 8) == 0) { if (r * 8 <= G) p.f = 8; else if (r * 4 <= G) p.f = 4; else if (r * 2 <= G) p.f = 2; }
    if (p.f == 1) { p.tfull = p.T; p.tt = 0; } else { p.tfull = R * (G / 8); p.tt = p.T - p.tfull; }
    return p;
}
struct DownOrder {
    int G, c; bool tail; DownPlan p; int tstart[9];
    __device__ __forceinline__ bool next(int i, Unit& u) const {
        const int L = i * G + c;
        if (!tail) { if (L >= p.tfull * 8) return false; u.pm = L >> 3; u.pn = L & 7; u.ks = 0; }
        else { if (L >= p.tt * 8 * p.f) return false; u.ks = L % p.f; const int q = L / p.f; u.pn = q & 7; u.pm = p.tfull + (q >> 3); }
        int es = 0;
#pragma unroll
        for (int e = 1; e < 8; ++e) if (u.pm >= tstart[e]) es = e;
        u.e = es; return true;
    }
    __device__ __forceinline__ void a_ready(const Unit&) const {}
    __device__ __forceinline__ void done(const Unit&) const {}
};
__device__ __forceinline__ unsigned cvt_pk_bf16(float lo, float hi) { unsigned r; asm volatile("v_cvt_pk_bf16_f32 %0, %1, %2" : "=v"(r) : "v"(lo), "v"(hi)); return r; }
struct EpiF32 {
    static constexpr bool PERM = false, AFTER_DRAIN = false;
    float* C; int ldc;
    __device__ __forceinline__ void operator()(const f32x4 (&acc)[2][2][4][2], const Unit& u, int wr, int wc, int fr, int fq) const {
        const int row0 = u.pm * BM + wr * 64 + fr, col0 = u.pn * BM + wc * 32 + 4 * fq;
#pragma unroll
        for (int ai = 0; ai < 2; ++ai)
#pragma unroll
            for (int m = 0; m < 4; ++m) { float* rowp = C + (size_t)(row0 + ai * HALF + m * 16) * ldc + col0;
#pragma unroll
                for (int bj = 0; bj < 2; ++bj)
#pragma unroll
                    for (int n = 0; n < 2; ++n) *(f32x4*)(rowp + bj * HALF + n * 16) = acc[ai][bj][m][n]; }
    }
};
struct EpiBf16 {
    static constexpr bool PERM = true, AFTER_DRAIN = false;
    bf16_t* O; int ldc;
    __device__ __forceinline__ void operator()(const f32x4 (&acc)[2][2][4][2], const Unit& u, int wr, int wc, int fr, int fq) const {
        const int row0 = u.pm * BM + wr * 64 + fr, col0 = u.pn * BM + wc * 32 + 8 * fq;
#pragma unroll
        for (int ai = 0; ai < 2; ++ai)
#pragma unroll
            for (int m = 0; m < 4; ++m) { bf16_t* rowp = O + (size_t)(row0 + ai * HALF + m * 16) * ldc + col0;
#pragma unroll
                for (int bj = 0; bj < 2; ++bj) { const f32x4 v0 = acc[ai][bj][m][0], v1 = acc[ai][bj][m][1];
                    u32x4 w; w.x = cvt_pk_bf16(v0[0], v0[1]); w.y = cvt_pk_bf16(v0[2], v0[3]); w.z = cvt_pk_bf16(v1[0], v1[1]); w.w = cvt_pk_bf16(v1[2], v1[3]);
                    *(u32x4*)(rowp + bj * HALF) = w; } }
    }
};
struct EpiBf16Gate {
    static constexpr bool PERM = true, AFTER_DRAIN = false;
    bf16_t* O; int ldc; float* G; int gc0;
    __device__ __forceinline__ void operator()(const f32x4 (&acc)[2][2][4][2], const Unit& u, int wr, int wc, int fr, int fq) const {
        EpiBf16{O, ldc}(acc, u, wr, wc, fr, fq);
        const int c0 = u.pn * BM + wc * 32 + 8 * fq - gc0;
        if (c0 >= 0 && c0 < 16) { const int row0 = u.pm * BM + wr * 64 + fr;
#pragma unroll
            for (int ai = 0; ai < 2; ++ai)
#pragma unroll
                for (int m = 0; m < 4; ++m) { float* gp = G + (size_t)(row0 + ai * HALF + m * 16) * 16 + c0; *(f32x4*)gp = acc[ai][0][m][0]; *(f32x4*)(gp + 4) = acc[ai][0][m][1]; } }
    }
};
struct EpiF32Part {
    static constexpr bool PERM = false, AFTER_DRAIN = false;
    float* P; int ldc, tfull, f;
    __device__ __forceinline__ void operator()(const f32x4 (&acc)[2][2][4][2], const Unit& u, int wr, int wc, int fr, int fq) const {
        const int row0 = ((u.pm - tfull) * f + u.ks) * BM + wr * 64 + fr, col0 = u.pn * BM + wc * 32 + 4 * fq;
#pragma unroll
        for (int ai = 0; ai < 2; ++ai)
#pragma unroll
            for (int m = 0; m < 4; ++m) { float* rowp = P + (size_t)(row0 + ai * HALF + m * 16) * ldc + col0;
#pragma unroll
                for (int bj = 0; bj < 2; ++bj)
#pragma unroll
                    for (int n = 0; n < 2; ++n) *(f32x4*)(rowp + bj * HALF + n * 16) = acc[ai][bj][m][n]; }
    }
};
struct EpiBf16Part {
    static constexpr bool PERM = true, AFTER_DRAIN = false;
    bf16_t* P; int ldc, tfull, f;
    __device__ __forceinline__ void operator()(const f32x4 (&acc)[2][2][4][2], const Unit& u, int wr, int wc, int fr, int fq) const {
        const int row0 = ((u.pm - tfull) * f + u.ks) * BM + wr * 64 + fr, col0 = u.pn * BM + wc * 32 + 8 * fq;
#pragma unroll
        for (int ai = 0; ai < 2; ++ai)
#pragma unroll
            for (int m = 0; m < 4; ++m) { bf16_t* rowp = P + (size_t)(row0 + ai * HALF + m * 16) * ldc + col0;
#pragma unroll
                for (int bj = 0; bj < 2; ++bj) { const f32x4 v0 = acc[ai][bj][m][0], v1 = acc[ai][bj][m][1];
                    u32x4 w; w.x = cvt_pk_bf16(v0[0], v0[1]); w.y = cvt_pk_bf16(v0[2], v0[3]); w.z = cvt_pk_bf16(v1[0], v1[1]); w.w = cvt_pk_bf16(v1[2], v1[3]);
                    *(u32x4*)(rowp + bj * HALF) = w; } }
    }
};
__device__ __forceinline__ float silu_fast(float v) { return v * __builtin_amdgcn_rcpf(1.f + __builtin_amdgcn_exp2f(-1.4426950408889634f * v)); }
struct EpiSwiglu {
    static constexpr bool PERM = true, AFTER_DRAIN = false;
    bf16_t* O; int ldc;
    __device__ __forceinline__ void operator()(const f32x4 (&acc)[2][2][4][2], const Unit& u, int wr, int wc, int fr, int fq) const {
        const int row0 = u.pm * BM + wr * 64 + fr, col0 = u.pn * HALF + wc * 32 + 8 * fq;
#pragma unroll
        for (int ai = 0; ai < 2; ++ai)
#pragma unroll
            for (int m = 0; m < 4; ++m) { bf16_t* rowp = O + (size_t)(row0 + ai * HALF + m * 16) * ldc + col0;
                const f32x4 g0 = acc[ai][0][m][0], g1 = acc[ai][0][m][1], u0 = acc[ai][1][m][0], u1 = acc[ai][1][m][1];
                u32x4 w; w.x = cvt_pk_bf16(silu_fast(g0[0]) * u0[0], silu_fast(g0[1]) * u0[1]); w.y = cvt_pk_bf16(silu_fast(g0[2]) * u0[2], silu_fast(g0[3]) * u0[3]);
                w.z = cvt_pk_bf16(silu_fast(g1[0]) * u1[0], silu_fast(g1[1]) * u1[1]); w.w = cvt_pk_bf16(silu_fast(g1[2]) * u1[2], silu_fast(g1[3]) * u1[3]);
                __builtin_nontemporal_store(w, (u32x4*)rowp); }
    }
};

template <class Epi, class Sched, bool ALIGN_EPI = false, bool SP2 = false>
__device__ __forceinline__ void gemm_phase(PG8_LAS unsigned char* lds, const Gemm g, const Sched& S, const Epi& E) {
    const int tid = opq_tid(), wid = __builtin_amdgcn_readfirstlane(tid >> 6), lane = tid & 63, wr = wid >> 2, wc = wid & 3, fr = lane & 15, fq = lane >> 4;
    const int K = g.K, nt = K / BK, LD = g.ldk;
    unsigned voffA[2], voffB[2];
#pragma unroll
    for (int i = 0; i < 2; ++i) { int R, C; stage_rc(tid * 16 + i * 8192, R, C); const int Rb = Epi::PERM ? ((R & ~31) + perm32(R & 31)) : R;
        voffA[i] = (unsigned)(R * LD + C) * 2u; voffB[i] = (unsigned)(Rb * LD + C) * 2u; }
    const size_t kstep = (size_t)(BK * 2);
    const size_t hstep = (size_t)HALF * LD * 2;
    const size_t tstep = 2 * hstep;
    const unsigned ldsw = (unsigned)wid * 1024u;
    const int aoff = lds_byte(wr * 64 + fr, fq * 8), boff = lds_byte(wc * 32 + fr, fq * 8);
#define PG8_SA(b, h) (((b) * 2 + (h)) * HTB)
#define PG8_SB(b, h) ((4 + (b) * 2 + (h)) * HTB)
#define PG8_STAGE(bufoff, gbase, voff) do { _Pragma("unroll") for (int _i = 0; _i < 2; ++_i) \
        __builtin_amdgcn_global_load_lds((const unsigned*)((const char*)(gbase) + (voff)[_i]), (PG8_LAS unsigned*)(lds + (bufoff) + ldsw + _i * 8192), 16, 0, 0); } while (0)
#define PG8_LDA(dst, b, h) do { _Pragma("unroll") for (int m = 0; m < 4; ++m) _Pragma("unroll") for (int k = 0; k < 2; ++k) dst[m][k] = *(const PG8_LAS bf16x8*)(lds + PG8_SA(b, h) + aoff + m * 2048 + k * 1024); } while (0)
#define PG8_LDB(dst, b, h) do { _Pragma("unroll") for (int n = 0; n < 2; ++n) _Pragma("unroll") for (int k = 0; k < 2; ++k) dst[n][k] = *(const PG8_LAS bf16x8*)(lds + PG8_SB(b, h) + boff + n * 2048 + k * 1024); } while (0)
#define PG8_MMA(ai, bj, At, Bt) do { __builtin_amdgcn_s_setprio(1); _Pragma("unroll") for (int m = 0; m < 4; ++m) _Pragma("unroll") for (int n = 0; n < 2; ++n) _Pragma("unroll") for (int k = 0; k < 2; ++k) \
        acc[ai][bj][m][n] = __builtin_amdgcn_mfma_f32_16x16x32_bf16(Bt[n][k], At[m][k], acc[ai][bj][m][n], 0, 0, 0); __builtin_amdgcn_s_setprio(0); } while (0)
#define PG8_WAIT_V(n) asm volatile("s_waitcnt vmcnt(" #n ")" ::: "memory")
#define PG8_WAIT_L(n) asm volatile("s_waitcnt lgkmcnt(" #n ")" ::: "memory")
#define PG8_BAR __builtin_amdgcn_s_barrier()
#define PG8_SCHED __builtin_amdgcn_sched_barrier(0)
    Unit cur, nxt; int ui = 0;
    if (!S.next(0, cur)) return;
    f32x4 acc[2][2][4][2];
#pragma unroll
    for (int a = 0; a < 2; ++a)
#pragma unroll
        for (int b = 0; b < 2; ++b)
#pragma unroll
            for (int m = 0; m < 4; ++m)
#pragma unroll
                for (int n = 0; n < 2; ++n) acc[a][b][m][n] = (f32x4){0.f, 0.f, 0.f, 0.f};
    bf16x8 At[4][2], B0[2][2], B1[2][2];
    const char* cA = (const char*)g.A + (size_t)cur.pm * tstep + (size_t)cur.ks * K * 2; const char* cB = (const char*)g.Bt + (size_t)cur.e * g.gbytes + (size_t)cur.pn * tstep + (size_t)cur.ks * K * 2;
    S.a_ready(cur);
    if constexpr (SP2) {
        PG8_STAGE(PG8_SB(0, 0), cB, voffB); PG8_STAGE(PG8_SB(0, 1), cB + hstep, voffB); PG8_STAGE(PG8_SA(0, 0), cA, voffA); PG8_STAGE(PG8_SA(0, 1), cA + hstep, voffA);
        if (wr == 1) PG8_BAR;
        PG8_WAIT_V(2); PG8_BAR;
        PG8_STAGE(PG8_SB(1, 0), cB + kstep, voffB); PG8_STAGE(PG8_SA(1, 0), cA + kstep, voffA); PG8_STAGE(PG8_SB(1, 1), cB + hstep + kstep, voffB);
        PG8_WAIT_V(6); PG8_BAR;
    } else {
        PG8_STAGE(PG8_SB(0, 0), cB, voffB); PG8_STAGE(PG8_SA(0, 0), cA, voffA); PG8_STAGE(PG8_SB(0, 1), cB + hstep, voffB); PG8_STAGE(PG8_SA(0, 1), cA + hstep, voffA);
        if (wr == 1) PG8_BAR;
        PG8_WAIT_V(4); PG8_BAR;
        PG8_STAGE(PG8_SB(1, 0), cB + kstep, voffB); PG8_STAGE(PG8_SA(1, 0), cA + kstep, voffA); PG8_STAGE(PG8_SB(1, 1), cB + hstep + kstep, voffB);
        PG8_WAIT_V(6); PG8_BAR;
    }
    for (;;) {
        const bool has_next = S.next(ui + 1, nxt);
        const char* nA = has_next ? (const char*)g.A + (size_t)nxt.pm * tstep + (size_t)nxt.ks * K * 2 : cA; const char* nB = has_next ? (const char*)g.Bt + (size_t)nxt.e * g.gbytes + (size_t)nxt.pn * tstep + (size_t)nxt.ks * K * 2 : cB;
        for (int t = 0; t < nt; t += 2) {
            const bool last = (t == nt - 2);
            const char* a1 = cA + (size_t)(t + 1) * kstep;
            const char* a2 = last ? nA : cA + (size_t)(t + 2) * kstep; const char* b2 = last ? nB : cB + (size_t)(t + 2) * kstep;
            const char* a3 = a2 + kstep; const char* b3 = b2 + kstep;
            if (last && has_next) S.a_ready(nxt);
            if constexpr (SP2) {
            PG8_LDB(B0, 0, 0); PG8_LDB(B1, 0, 1); PG8_SCHED; PG8_LDA(At, 0, 0); PG8_STAGE(PG8_SA(1, 1), a1 + hstep, voffA);
            PG8_WAIT_V(8); PG8_WAIT_L(0); PG8_BAR; PG8_MMA(0, 0, At, B0); PG8_MMA(0, 1, At, B1); PG8_BAR; PG8_SCHED;
            PG8_LDA(At, 0, 1); PG8_STAGE(PG8_SB(0, 0), b2, voffB); PG8_STAGE(PG8_SB(0, 1), b2 + hstep, voffB); PG8_STAGE(PG8_SA(0, 0), a2, voffA);
            PG8_WAIT_V(8); PG8_WAIT_L(0); PG8_BAR; PG8_MMA(1, 0, At, B0); PG8_MMA(1, 1, At, B1); PG8_BAR; PG8_SCHED;
            PG8_LDB(B0, 1, 0); PG8_LDB(B1, 1, 1); PG8_SCHED; PG8_LDA(At, 1, 0); PG8_STAGE(PG8_SA(0, 1), a2 + hstep, voffA);
            PG8_WAIT_V(8); PG8_WAIT_L(0); PG8_BAR; PG8_MMA(0, 0, At, B0); PG8_MMA(0, 1, At, B1); PG8_BAR; PG8_SCHED;
            PG8_LDA(At, 1, 1); PG8_STAGE(PG8_SB(1, 0), b3, voffB); PG8_STAGE(PG8_SB(1, 1), b3 + hstep, voffB); PG8_STAGE(PG8_SA(1, 0), a3, voffA);
            PG8_WAIT_V(8); PG8_WAIT_L(0); PG8_BAR; PG8_MMA(1, 0, At, B0); PG8_MMA(1, 1, At, B1); PG8_BAR; PG8_SCHED;
            } else {
            PG8_LDB(B0, 0, 0); PG8_SCHED; PG8_LDA(At, 0, 0); PG8_STAGE(PG8_SA(1, 1), a1 + hstep, voffA);
            PG8_WAIT_L(8); PG8_BAR; PG8_WAIT_L(0); PG8_MMA(0, 0, At, B0); PG8_BAR; PG8_SCHED;
            PG8_LDB(B1, 0, 1); PG8_STAGE(PG8_SB(0, 0), b2, voffB);
            PG8_BAR; PG8_WAIT_L(0); PG8_MMA(0, 1, At, B1); PG8_BAR;
            PG8_LDA(At, 0, 1); PG8_STAGE(PG8_SA(0, 0), a2, voffA);
            PG8_BAR; PG8_WAIT_L(0); PG8_MMA(1, 0, At, B0); PG8_BAR; PG8_SCHED;
            PG8_STAGE(PG8_SB(0, 1), b2 + hstep, voffB);
            PG8_WAIT_V(6); PG8_BAR; PG8_MMA(1, 1, At, B1); PG8_BAR;
            PG8_LDB(B0, 1, 0); PG8_SCHED; PG8_LDA(At, 1, 0); PG8_STAGE(PG8_SA(0, 1), a2 + hstep, voffA);
            PG8_WAIT_L(8); PG8_BAR; PG8_WAIT_L(0); PG8_MMA(0, 0, At, B0); PG8_BAR; PG8_SCHED;
            PG8_LDB(B1, 1, 1); PG8_STAGE(PG8_SB(1, 0), b3, voffB);
            PG8_BAR; PG8_WAIT_L(0); PG8_MMA(0, 1, At, B1); PG8_BAR;
            PG8_LDA(At, 1, 1); PG8_STAGE(PG8_SA(1, 0), a3, voffA);
            PG8_BAR; PG8_WAIT_L(0); PG8_MMA(1, 0, At, B0); PG8_BAR; PG8_SCHED;
            PG8_STAGE(PG8_SB(1, 1), b3 + hstep, voffB);
            PG8_WAIT_V(6); PG8_BAR; PG8_MMA(1, 1, At, B1); PG8_BAR;
            }
        }
        if constexpr (ALIGN_EPI) { if (wr == 0) PG8_BAR; }
        if constexpr (!Epi::AFTER_DRAIN) { E(acc, cur, wr, wc, fr, fq); S.done(cur); }
        if (!has_next) break;
#pragma unroll
        for (int a = 0; a < 2; ++a)
#pragma unroll
            for (int b = 0; b < 2; ++b)
#pragma unroll
                for (int m = 0; m < 4; ++m)
#pragma unroll
                    for (int n = 0; n < 2; ++n) acc[a][b][m][n] = (f32x4){0.f, 0.f, 0.f, 0.f};
        cur = nxt; cA = nA; cB = nB; ++ui;
        if constexpr (ALIGN_EPI) { if (wr == 1) PG8_BAR; }
    }
    PG8_WAIT_V(0);
    if constexpr (!ALIGN_EPI) { if (wr == 0) PG8_BAR; }
    PG8_BAR;
    if constexpr (Epi::AFTER_DRAIN) { E.fused(acc, cur, wr, wc, fr, fq, lds, wid, lane); S.done(cur); }
#undef PG8_SA
#undef PG8_SB
#undef PG8_STAGE
#undef PG8_LDA
#undef PG8_LDB
#undef PG8_MMA
#undef PG8_WAIT_V
#undef PG8_WAIT_L
#undef PG8_BAR
#undef PG8_SCHED
}
}

struct CvtJob { const GAS float* W; GAS bf16* WT; int K, N, nblk, map, item; };
__device__ __forceinline__ const float* cvt_opq(const float* p) { asm volatile("" : "+s"(p)); return p; }
__device__ __forceinline__ CvtJob cvt_decode(const Args& a, unsigned char* ws, int g) {
    const float* W; bf16* WT; int K, N, nblk, map = 0, item;
#define CVW(p) cvt_opq(p)
    if (g < 3856) {
        const int l = g >= 2984 ? 1 : 0;
        const int r = g < 872 ? g : (g < 2984 ? -1 : g - 2984);
        if (r >= 0) {
            if (r < 576) { W = CVW(LIN(2)); WT = (bf16*)(ws + O_WIN) + (size_t)l * DINP * D; K = D; N = DIN; nblk = DINP / 256; item = r; }
            else if (r < 600) { W = CVW(LIN(6)); WT = (bf16*)(ws + O_WUQ) + (size_t)l * 768 * 512; K = 512; N = 768; nblk = 3; item = r - 576; }
            else if (r < 616) { W = CVW(LIN(8)); WT = (bf16*)(ws + O_WUKV) + (size_t)l * 1024 * 256; K = 256; N = 1024; nblk = 4; item = r - 600; }
            else { W = CVW(LIN(12)); WT = (bf16*)(ws + O_WOUT) + (size_t)l * D * D; K = D; N = D; nblk = 8; item = r - 616; }
        } else { const int q = g - 872, m = q / 704; item = q % 704;
            if (m == 0) { W = CVW(a.in[17]); WT = (bf16*)(ws + O_WGU0); K = D; N = FF0; nblk = FF0 / 256; map = 1; }
            else if (m == 1) { W = CVW(a.in[18]); WT = (bf16*)(ws + O_WGU0); K = D; N = FF0; nblk = FF0 / 256; map = 2; }
            else { W = CVW(a.in[19]); WT = (bf16*)(ws + O_WD0); K = FF0; N = D; nblk = 8; }
        }
    } else { const int r = g - 3856, e = r / 2688, rr = r % 2688, m = rr / 896; item = rr % 896;
        if (m == 0) { W = CVW(a.in[38] + (size_t)e * D * FF1); WT = (bf16*)(ws + O_WGU1) + (size_t)e * 2 * FF1 * D; K = D; N = FF1; nblk = FF1 / 256; map = 1; }
        else if (m == 1) { W = CVW(a.in[39] + (size_t)e * D * FF1); WT = (bf16*)(ws + O_WGU1) + (size_t)e * 2 * FF1 * D; K = D; N = FF1; nblk = FF1 / 256; map = 2; }
        else { W = CVW(a.in[40] + (size_t)e * FF1 * D); WT = (bf16*)(ws + O_WD1) + (size_t)e * D * FF1; K = FF1; N = D; nblk = 8; }
    }
#undef CVW
    return CvtJob{(const GAS float*)W, (GAS bf16*)WT, K, N, nblk, map, item};
}
constexpr int CVT_ITEMS = 3856 + 8 * 2688, CVT_EARLY = 616;
constexpr int CVT_M0 = 28, CVT_M1 = 20, CVT_G0 = 21, CVT_G1 = 16, CVT_U0 = 28, CVT_U1 = 21;
constexpr int CVT_L1 = CVT_EARLY + 128 * CVT_M0 + 512 * CVT_G0;
static_assert(128 * CVT_M0 + 512 * CVT_G0 == 512 * CVT_U0 && CVT_L1 >= 3856 && CVT_L1 + 128 * CVT_M1 + 512 * CVT_G1 >= CVT_ITEMS && CVT_L1 + 512 * CVT_U1 >= CVT_ITEMS, "conversion shares");
__device__ __forceinline__ void cvt_load(const CvtJob& j, int c, int q, f32x4 (&v)[8]) {
    const int kb = j.item / j.nblk, nb = j.item % j.nblk, k0 = 64 * kb + 8 * (q >> 3), n = 256 * nb + 32 * c + 4 * (q & 7);
    if (n < j.N) {
#pragma unroll
        for (int i = 0; i < 8; ++i) v[i] = __builtin_nontemporal_load((const GAS f32x4*)(j.W + (size_t)(k0 + i) * j.N + n));
    } else {
#pragma unroll
        for (int i = 0; i < 8; ++i) v[i] = (f32x4){0.f, 0.f, 0.f, 0.f};
    }
}
__device__ __forceinline__ void cvt_store(const CvtJob& j, int c, int q, const f32x4 (&v)[8]) {
    const int kb = j.item / j.nblk, nb = j.item % j.nblk, k0 = 64 * kb + 8 * (q >> 3), n = 256 * nb + 32 * c + 4 * (q & 7);
    const int r0 = j.map == 0 ? n : (256 * (n >> 7) + (n & 127) + (j.map == 2 ? 128 : 0));
#pragma unroll
    for (int jj = 0; jj < 4; ++jj) {
        v4u o; o.x = pg8::cvt_pk_bf16(v[0][jj], v[1][jj]); o.y = pg8::cvt_pk_bf16(v[2][jj], v[3][jj]); o.z = pg8::cvt_pk_bf16(v[4][jj], v[5][jj]); o.w = pg8::cvt_pk_bf16(v[6][jj], v[7][jj]);
        *(GAS v4u*)(j.WT + (size_t)(r0 + jj) * j.K + k0) = o; }
}
__device__ __forceinline__ void ph_convert(const Frame& F, const Args& a, int g0, int g1) {
    const int c = F.wave, q = F.lane, st = F.nblk;
    f32x4 va[8], vb[8];
    int g = g0 + F.bid;
    if (g < g1) cvt_load(cvt_decode(a, F.ws, g), c, q, va);
    for (; g < g1; g += 2 * st) {
        const bool hb = g + st < g1;
        if (hb) cvt_load(cvt_decode(a, F.ws, g + st), c, q, vb);
        cvt_store(cvt_decode(a, F.ws, g), c, q, va);
        if (hb) { if (g + 2 * st < g1) cvt_load(cvt_decode(a, F.ws, g + 2 * st), c, q, va); cvt_store(cvt_decode(a, F.ws, g + st), c, q, vb); }
    }
}
__device__ __forceinline__ void ph_mod_fast(const Frame& F, const Args& a) {
    LAS float* ca = (LAS float*)F.lds; LAS float* part = ca + 2048;
    for (int k = F.tid; k < D; k += NTHR) ca[k] = siluf(a.in[1][k]);
    __syncthreads();
    float* mod = (float*)(F.ws + O_MOD);
    const int kk = F.tid >> 3, c4 = F.tid & 7;
    for (int strip = F.bid; strip < 768; strip += F.nblk) {
        const int l = strip / 384, j0 = (strip % 384) * 32;
        const float* W = (l ? a.in[22] : a.in[2]) + j0 + 4 * c4;
        f32x4 acc = {0.f, 0.f, 0.f, 0.f};
#pragma unroll 8
        for (int i = 0; i < 32; ++i) { const int k = kk + 64 * i; acc += __builtin_nontemporal_load((const f32x4*)(W + (size_t)k * NMOD)) * ca[k]; }
        *(LAS f32x4*)(part + kk * 32 + 4 * c4) = acc;
        __syncthreads();
        if (F.tid < 32) { float sacc = (l ? a.in[23] : a.in[3])[j0 + F.tid];
#pragma unroll 8
            for (int r = 0; r < 64; ++r) sacc += part[r * 32 + F.tid];
            mod[l * NMOD + j0 + F.tid] = sacc; }
        __syncthreads();
    }
}
template <class Epi>
__device__ __forceinline__ void fgemm(const Frame& F, const bf16* A, const bf16* Bt, int M, int N, int K, const Epi& E, int rot = 0) {
    int cid = F.bid + rot; if (cid >= F.nblk) cid -= F.nblk;
    pg8::Gemm g{A, Bt, M, N, K, 0, K}; pg8::StaticOrder So; So.init(M, N, F.nblk, cid);
    pg8::gemm_phase<Epi, pg8::StaticOrder, true, true>(F.lds, g, So, E);
}
template <class Epi>
__device__ __forceinline__ void fgemm_grouped(const Frame& F, const bf16* A, const bf16* Bt, int N, int K, size_t gbytes, const Seg& seg, const Epi& E) {
    pg8::Gemm g{A, Bt, MPAD, N, K, gbytes, K}; pg8::GroupedOrder So; So.nN = N / 256; So.G = F.nblk; So.c = F.bid;
#pragma unroll
    for (int i = 0; i < 9; ++i) So.tstart[i] = seg.start[i] >> 8;
    pg8::gemm_phase<Epi, pg8::GroupedOrder, true, true>(F.lds, g, So, E);
}

namespace fa {
using bf16x8 = __attribute__((ext_vector_type(8))) short;
using s16x4  = __attribute__((ext_vector_type(4))) short;
using f32x16 = __attribute__((ext_vector_type(16))) float;
using u32x4  = __attribute__((ext_vector_type(4))) unsigned;
constexpr int NW = 8, QBLK = 32, KVBLK = 64;
#define FA_SBAR() __builtin_amdgcn_sched_barrier(0)
__device__ __forceinline__ int crow(int r, int hi) { return (r & 3) + 8 * (r >> 2) + 4 * hi; }
__device__ __forceinline__ unsigned cvtpk(float lo, float hi) { unsigned r; asm volatile("v_cvt_pk_bf16_f32 %0, %1, %2" : "=v"(r) : "v"(lo), "v"(hi)); return r; }
template <int DQK> __device__ __forceinline__ int kswz(int row, int colB) { return row * (DQK * 2) + (colB ^ (((row >> 1) & 7) << 4)); }
template <int NB> __device__ __forceinline__ int v_st(int k, int c) { const int kk = (k & ~0xC) | ((k & 4) << 1) | ((k & 8) >> 1); return ((kk >> 3) * NB + (c >> 5)) * 512 + ((kk & 7) * 32 + (c & 31)) * 2; }
__device__ __forceinline__ int v_rd_base(int lane) { return ((lane & 3) << 3) | (((lane >> 2) & 3) << 6) | (((lane >> 4) & 1) << 5) | (((lane >> 5) & 1) << 8); }
template <int OFF> __device__ __forceinline__ s16x4 tr_read(int vb) { s16x4 r; asm volatile("ds_read_b64_tr_b16 %0, %1 offset:%2" : "=&v"(r) : "v"(vb), "i"(OFF) : "memory"); return r; }

__device__ __forceinline__ void partialSM(f32x16& p0, f32x16& p1, float& m_reg, float& mn, float& alpha, const float C, const float thr_raw) {
  float pmax = p0[0];
#pragma unroll
  for (int r = 1; r < 16; ++r) pmax = fmaxf(pmax, p0[r]);
#pragma unroll
  for (int r = 0; r < 16; ++r) pmax = fmaxf(pmax, p1[r]);
  { auto rr = __builtin_amdgcn_permlane32_swap(__float_as_uint(pmax), __float_as_uint(pmax), false, false);
    pmax = fmaxf(__uint_as_float(rr[0]), __uint_as_float(rr[1])); }
  if (__builtin_expect(__all(pmax - m_reg <= thr_raw), 1)) { mn = m_reg; alpha = 1.f; }
  else { mn = fmaxf(m_reg, pmax); alpha = __builtin_amdgcn_exp2f((m_reg - mn) * C); m_reg = mn; }
  const float mnC = -mn * C;
#pragma unroll
  for (int r = 0; r < 16; ++r) p0[r] = fmaf(p0[r], C, mnC);
#pragma unroll
  for (int r = 0; r < 16; ++r) p1[r] = fmaf(p1[r], C, mnC);
#pragma unroll
  for (int r = 0; r < 16; ++r) p0[r] = __builtin_amdgcn_exp2f(p0[r]);
}
__device__ __forceinline__ void finishSM(f32x16& p0, f32x16& p1, float alpha, float& l_reg, bf16x8& pa0, bf16x8& pa1, bf16x8& pa2, bf16x8& pa3) {
#pragma unroll
  for (int r = 0; r < 16; ++r) p1[r] = __builtin_amdgcn_exp2f(p1[r]);
  float ps = 0;
#pragma unroll
  for (int r = 0; r < 16; ++r) ps += p0[r];
#pragma unroll
  for (int r = 0; r < 16; ++r) ps += p1[r];
  { auto rr = __builtin_amdgcn_permlane32_swap(__float_as_uint(ps), __float_as_uint(ps), false, false);
    ps = __uint_as_float(rr[0]) + __uint_as_float(rr[1]); }
  l_reg = l_reg * alpha + ps;
#define FA_PK4(P, BASE, OUT) do { unsigned a0 = cvtpk(P[BASE + 0], P[BASE + 1]), a1 = cvtpk(P[BASE + 2], P[BASE + 3]);   \
    unsigned b0 = cvtpk(P[BASE + 4], P[BASE + 5]), b1 = cvtpk(P[BASE + 6], P[BASE + 7]);                              \
    auto r0 = __builtin_amdgcn_permlane32_swap(a0, b0, false, false); auto r1 = __builtin_amdgcn_permlane32_swap(a1, b1, false, false); \
    u32x4 w = {r0[0], r1[0], r0[1], r1[1]}; OUT = __builtin_bit_cast(bf16x8, w); } while (0)
  FA_PK4(p0, 0, pa0); FA_PK4(p0, 8, pa1); FA_PK4(p1, 0, pa2); FA_PK4(p1, 8, pa3);
#undef FA_PK4
}
template <int DQK>
__device__ __forceinline__ void qkt(f32x16& p0, f32x16& p1, const LAS char* Ks, const bf16x8* qr, int r32, int hi) {
  p0 = f32x16{}; p1 = f32x16{};
#pragma unroll
  for (int d0 = 0; d0 < DQK / 16; ++d0) { const int cb = (d0 * 16 + hi * 8) * 2;
    const bf16x8 b0 = *(const LAS bf16x8*)(Ks + kswz<DQK>(r32, cb));
    const bf16x8 b1 = *(const LAS bf16x8*)(Ks + kswz<DQK>(32 + r32, cb));
    p0 = __builtin_amdgcn_mfma_f32_32x32x16_bf16(b0, qr[d0], p0, 0, 0, 0);
    p1 = __builtin_amdgcn_mfma_f32_32x32x16_bf16(b1, qr[d0], p1, 0, 0, 0); }
}
template <int D0, int NB> __device__ __forceinline__ void pv_one(f32x16& od, int vb, bf16x8 pa0, bf16x8 pa1, bf16x8 pa2, bf16x8 pa3) {
#define FA_VO(ks, half) (((2 * (ks) + (half)) * NB + D0) * 512)
  const s16x4 l0 = tr_read<FA_VO(0, 0)>(vb), h0 = tr_read<FA_VO(0, 1)>(vb), l1 = tr_read<FA_VO(1, 0)>(vb), h1 = tr_read<FA_VO(1, 1)>(vb);
  const s16x4 l2 = tr_read<FA_VO(2, 0)>(vb), h2 = tr_read<FA_VO(2, 1)>(vb), l3 = tr_read<FA_VO(3, 0)>(vb), h3 = tr_read<FA_VO(3, 1)>(vb);
#undef FA_VO
  asm volatile("s_waitcnt lgkmcnt(0)" ::: "memory"); FA_SBAR();
#define FA_PK(L, H) (bf16x8){L[0], L[1], L[2], L[3], H[0], H[1], H[2], H[3]}
  od = __builtin_amdgcn_mfma_f32_32x32x16_bf16(pa0, FA_PK(l0, h0), od, 0, 0, 0);
  od = __builtin_amdgcn_mfma_f32_32x32x16_bf16(pa1, FA_PK(l1, h1), od, 0, 0, 0);
  od = __builtin_amdgcn_mfma_f32_32x32x16_bf16(pa2, FA_PK(l2, h2), od, 0, 0, 0);
  od = __builtin_amdgcn_mfma_f32_32x32x16_bf16(pa3, FA_PK(l3, h3), od, 0, 0, 0);
#undef FA_PK
}
template <int NB> __device__ __forceinline__ void pv_all(f32x16* o, int vb, bf16x8 pa0, bf16x8 pa1, bf16x8 pa2, bf16x8 pa3) {
  pv_one<0, NB>(o[0], vb, pa0, pa1, pa2, pa3); pv_one<1, NB>(o[1], vb, pa0, pa1, pa2, pa3);
  if constexpr (NB == 4) { pv_one<2, NB>(o[2], vb, pa0, pa1, pa2, pa3); pv_one<3, NB>(o[3], vb, pa0, pa1, pa2, pa3); }
}
template <int DQK, int DV, int SD, bool CVT>
__device__ __forceinline__ void attn_unit(const bf16* __restrict__ Qb, const int ldq, const bf16* __restrict__ Kh, const int ldk, const bf16* __restrict__ Vh, const int ldv,
                                          bf16* __restrict__ Ob, const int ldo, const int seq, const float scale, LAS char* lds, const Args& cva, unsigned char* cvws, int cv0, const int cv1, const int cvper) {
  constexpr int NB = DV / 32, NQ = DQK / 16, SHM_V = KVBLK * DV * 2, SHM_K = KVBLK * DQK * 2;
  constexpr int CPK = DQK / 8, CPV = DV / 8, PK = KVBLK * CPK / 512, PV = KVBLK * CPV / 512;
  static_assert(KVBLK * CPK % 512 == 0 && KVBLK * CPV % 512 == 0, "tile chunks must divide over 512 threads");
  const int tid = opq_tid(), wid = __builtin_amdgcn_readfirstlane(tid >> 6), lane = tid & 63, r32 = lane & 31, hi = lane >> 5;
  LAS char* V_lds = lds; LAS char* K_lds = lds + 2 * SHM_V;
  LAS float* wsf = (LAS float*)(lds + 2 * SHM_V + 2 * SHM_K) + wid * 64; LAS float* li_l = wsf; LAS float* al_l = wsf + 32;
  const float C = scale * 1.4426950408889634f, thr_raw = 8.f / scale;
  float m_reg = -1e30f, l_reg = 0; f32x16 o[NB]; bf16x8 qr[NQ];
#pragma unroll
  for (int d = 0; d < NB; ++d) o[d] = f32x16{};
  const bf16* Qw = Qb + (long)(wid * QBLK + r32) * ldq + hi * 8;
#pragma unroll
  for (int d0 = 0; d0 < NQ; ++d0) qr[d0] = *reinterpret_cast<const bf16x8*>(Qw + d0 * 16);
  int krow[PK], kcol[PK], vrow[PV], vcol[PV];
#pragma unroll
  for (int p = 0; p < PK; ++p) { const int idx = tid + 512 * p; krow[p] = idx / CPK; kcol[p] = (idx % CPK) * 8; }
#pragma unroll
  for (int p = 0; p < PV; ++p) { const int idx = tid + 512 * p; vrow[p] = idx / CPV; vcol[p] = (idx % CPV) * 8; }
  const int vb0 = (int)(uintptr_t)V_lds + v_rd_base(lane);
  bf16x8 sk[SD][PK], sv[SD][PV];
#define FA_SLOAD(i, k0) do { _Pragma("unroll") for (int p = 0; p < PV; ++p) sv[i][p] = *reinterpret_cast<const bf16x8*>(&Vh[(long)((k0) + vrow[p]) * ldv + vcol[p]]); \
    _Pragma("unroll") for (int p = 0; p < PK; ++p) sk[i][p] = *reinterpret_cast<const bf16x8*>(&Kh[(long)((k0) + krow[p]) * ldk + kcol[p]]); } while (0)
#define FA_SWRITE(b, i) do { _Pragma("unroll") for (int p = 0; p < PV; ++p) *(LAS bf16x8*)(V_lds + (b) * SHM_V + v_st<NB>(vrow[p], vcol[p])) = sv[i][p]; \
    _Pragma("unroll") for (int p = 0; p < PK; ++p) *(LAS bf16x8*)(K_lds + (b) * SHM_K + kswz<DQK>(krow[p], kcol[p] * 2)) = sk[i][p]; } while (0)
#define FA_RESC(a) do { if (__any((a) < 1.f)) { if (hi == 0) al_l[r32] = (a); asm volatile("s_waitcnt lgkmcnt(0)" ::: "memory"); \
    _Pragma("unroll") for (int d = 0; d < NB; ++d) _Pragma("unroll") for (int r = 0; r < 16; ++r) o[d][r] *= al_l[crow(r, hi)]; } } while (0)
  f32x16 pA0, pA1, pB0, pB1; float mnA, mnB, alA, alB; bf16x8 pa0, pa1, pa2, pa3; const int NT = seq / KVBLK;
  constexpr int SE = 0, SO = SD - 1;
  FA_SLOAD(SE, 0); asm volatile("s_waitcnt vmcnt(0)" ::: "memory"); FA_SWRITE(0, SE); __syncthreads();
  qkt<DQK>(pA0, pA1, K_lds, qr, r32, hi); partialSM(pA0, pA1, m_reg, mnA, alA, C, thr_raw);
  FA_SLOAD(SO, KVBLK); if constexpr (SD == 2) { if (2 < NT) FA_SLOAD(SE, 2 * KVBLK); }
  FA_SWRITE(1, SO); __syncthreads();
  f32x4 cvv[8]; CvtJob cvj; bool cvp = false; int cvt3 = 0;
  for (int j = 1; j + 1 < NT; j += 2) {
    if constexpr (CVT) {
      if (cvp) { cvt_store(cvj, wid, lane, cvv); cvp = false; }
      if (cvt3 == 0 && cv0 < cv1) { cvj = cvt_decode(cva, cvws, cv0); cvt_load(cvj, wid, lane, cvv); cvp = true; ++cv0; }
      cvt3 = cvt3 + 1 >= cvper ? 0 : cvt3 + 1;
    }
    FA_SBAR(); qkt<DQK>(pB0, pB1, K_lds + SHM_K, qr, r32, hi);
    finishSM(pA0, pA1, alA, l_reg, pa0, pa1, pa2, pa3); FA_SBAR();
    FA_SLOAD(SO, (j + SD) * KVBLK); FA_SBAR();
    pv_all<NB>(o, vb0, pa0, pa1, pa2, pa3); partialSM(pB0, pB1, m_reg, mnB, alB, C, thr_raw);
    __syncthreads(); FA_SWRITE(0, SE);
    FA_RESC(alB); __syncthreads();
    FA_SBAR(); qkt<DQK>(pA0, pA1, K_lds, qr, r32, hi);
    finishSM(pB0, pB1, alB, l_reg, pa0, pa1, pa2, pa3); FA_SBAR();
    if (SD == 1 || j + 3 < NT) FA_SLOAD(SE, (j + 1 + SD) * KVBLK); FA_SBAR();
    pv_all<NB>(o, vb0 + SHM_V, pa0, pa1, pa2, pa3); partialSM(pA0, pA1, m_reg, mnA, alA, C, thr_raw);
    __syncthreads(); FA_SWRITE(1, SO);
    FA_RESC(alA); __syncthreads();
  }
  if constexpr (CVT) { if (cvp) cvt_store(cvj, wid, lane, cvv); }
  FA_SBAR(); qkt<DQK>(pB0, pB1, K_lds + SHM_K, qr, r32, hi);
  finishSM(pA0, pA1, alA, l_reg, pa0, pa1, pa2, pa3); FA_SBAR();
  pv_all<NB>(o, vb0, pa0, pa1, pa2, pa3); partialSM(pB0, pB1, m_reg, mnB, alB, C, thr_raw);
  __syncthreads(); FA_RESC(alB);
  finishSM(pB0, pB1, alB, l_reg, pa0, pa1, pa2, pa3); FA_SBAR();
  pv_all<NB>(o, vb0 + SHM_V, pa0, pa1, pa2, pa3);
  if (hi == 0) li_l[r32] = l_reg; asm volatile("s_waitcnt lgkmcnt(0)" ::: "memory");
  float rli[16];
#pragma unroll
  for (int r = 0; r < 16; ++r) rli[r] = __builtin_amdgcn_rcpf(li_l[crow(r, hi)]);
  bf16* Ow = Ob + (long)(wid * QBLK) * ldo;
#pragma unroll
  for (int r = 0; r < 16; ++r) { const int orow = crow(r, hi);
#pragma unroll
    for (int d0 = 0; d0 < NB; ++d0) Ow[(long)orow * ldo + d0 * 32 + r32] = f2bf(o[d0][r] * rli[r]); }
  __syncthreads();
#undef FA_SLOAD
#undef FA_SWRITE
#undef FA_RESC
}
__device__ __forceinline__ void packP(const f32x16& p0, const f32x16& p1, bf16x8& pa0, bf16x8& pa1, bf16x8& pa2, bf16x8& pa3) {
#define FA_PK4(P, BASE, OUT) do { unsigned a0 = cvtpk(P[BASE + 0], P[BASE + 1]), a1 = cvtpk(P[BASE + 2], P[BASE + 3]);   \
    unsigned b0 = cvtpk(P[BASE + 4], P[BASE + 5]), b1 = cvtpk(P[BASE + 6], P[BASE + 7]);                              \
    auto r0 = __builtin_amdgcn_permlane32_swap(a0, b0, false, false); auto r1 = __builtin_amdgcn_permlane32_swap(a1, b1, false, false); \
    u32x4 w = {r0[0], r1[0], r0[1], r1[1]}; OUT = __builtin_bit_cast(bf16x8, w); } while (0)
  FA_PK4(p0, 0, pa0); FA_PK4(p0, 8, pa1); FA_PK4(p1, 0, pa2); FA_PK4(p1, 8, pa3);
#undef FA_PK4
}
template <int DQK>
__device__ __forceinline__ void qkt_init(f32x16& p0, f32x16& p1, const LAS char* Ks, const bf16x8* qr, int r32, int hi, const f32x16& init) {
  p0 = init; p1 = init;
#pragma unroll
  for (int d0 = 0; d0 < DQK / 16; ++d0) { const int cb = (d0 * 16 + hi * 8) * 2;
    const bf16x8 b0 = *(const LAS bf16x8*)(Ks + kswz<DQK>(r32, cb));
    const bf16x8 b1 = *(const LAS bf16x8*)(Ks + kswz<DQK>(32 + r32, cb));
    p0 = __builtin_amdgcn_mfma_f32_32x32x16_bf16(b0, qr[d0], p0, 0, 0, 0);
    p1 = __builtin_amdgcn_mfma_f32_32x32x16_bf16(b1, qr[d0], p1, 0, 0, 0); }
}
template <int NB> __device__ __forceinline__ void pv_sum(f32x16* o, int vb, bf16x8 pa0, bf16x8 pa1, bf16x8 pa2, bf16x8 pa3) {
  const bf16x8 ones = {0x3F80, 0x3F80, 0x3F80, 0x3F80, 0x3F80, 0x3F80, 0x3F80, 0x3F80};
  pv_all<NB>(o, vb, pa0, pa1, pa2, pa3);
  o[NB] = __builtin_amdgcn_mfma_f32_32x32x16_bf16(pa0, ones, o[NB], 0, 0, 0); o[NB] = __builtin_amdgcn_mfma_f32_32x32x16_bf16(pa1, ones, o[NB], 0, 0, 0);
  o[NB] = __builtin_amdgcn_mfma_f32_32x32x16_bf16(pa2, ones, o[NB], 0, 0, 0); o[NB] = __builtin_amdgcn_mfma_f32_32x32x16_bf16(pa3, ones, o[NB], 0, 0, 0);
}
template <int DQK, int DV, int SD, bool CVT>
__device__ __forceinline__ void attn_unit_fixed(const bf16* __restrict__ Qb, const int ldq, const bf16* __restrict__ Kh, const int ldk, const bf16* __restrict__ Vh, const int ldv,
                                                bf16* __restrict__ Ob, const int ldo, const int seq, LAS char* lds, const Args& cva, unsigned char* cvws, int cv0, const int cv1, const int cvper) {
  constexpr int NB = DV / 32, NQ = DQK / 16, SHM_V = KVBLK * DV * 2, SHM_K = KVBLK * DQK * 2;
  constexpr int CPK = DQK / 8, CPV = DV / 8, PK = KVBLK * CPK / 512, PV = KVBLK * CPV / 512;
  static_assert(KVBLK * CPK % 512 == 0 && KVBLK * CPV % 512 == 0, "tile chunks must divide over 512 threads");
  const int tid = opq_tid(), wid = __builtin_amdgcn_readfirstlane(tid >> 6), lane = tid & 63, r32 = lane & 31, hi = lane >> 5;
  LAS char* V_lds = lds; LAS char* K_lds = lds + 3 * SHM_V;
  static_assert(SD == 2, "two staging slots");
  f32x16 o[NB + 1]; bf16x8 qr[NQ];
#pragma unroll
  for (int d = 0; d <= NB; ++d) o[d] = f32x16{};
  const bf16* Qw = Qb + (long)(wid * QBLK + r32) * ldq + hi * 8;
#pragma unroll
  for (int d0 = 0; d0 < NQ; ++d0) qr[d0] = *reinterpret_cast<const bf16x8*>(Qw + d0 * 16);
  int krow[PK], kcol[PK], vrow[PV], vcol[PV];
#pragma unroll
  for (int p = 0; p < PK; ++p) { const int idx = tid + 512 * p; krow[p] = idx / CPK; kcol[p] = (idx % CPK) * 8; }
#pragma unroll
  for (int p = 0; p < PV; ++p) { const int idx = tid + 512 * p; vrow[p] = idx / CPV; vcol[p] = (idx % CPV) * 8; }
  const int vb0 = (int)(uintptr_t)V_lds + v_rd_base(lane);
  bf16x8 sk[SD][PK], sv[SD][PV];
#define FA_SLOAD(i, k0) do { _Pragma("unroll") for (int p = 0; p < PV; ++p) sv[i][p] = *(const GAS bf16x8*)(&Vh[(long)((k0) + vrow[p]) * ldv + vcol[p]]); \
    _Pragma("unroll") for (int p = 0; p < PK; ++p) sk[i][p] = *(const GAS bf16x8*)(&Kh[(long)((k0) + krow[p]) * ldk + kcol[p]]); } while (0)
#define FA_SWRITE(b, i) do { _Pragma("unroll") for (int p = 0; p < PV; ++p) *(LAS bf16x8*)(V_lds + (b) * SHM_V + v_st<NB>(vrow[p], vcol[p])) = sv[i][p]; \
    _Pragma("unroll") for (int p = 0; p < PK; ++p) *(LAS bf16x8*)(K_lds + (b) * SHM_K + kswz<DQK>(krow[p], kcol[p] * 2)) = sk[i][p]; } while (0)
#define FA_EXP(P) do { _Pragma("unroll") for (int r = 0; r < 16; ++r) P[r] = __builtin_amdgcn_exp2f(P[r]); } while (0)
  f32x16 pA0, pA1, pB0, pB1; bf16x8 pa0, pa1, pa2, pa3; const int NT = seq / KVBLK;
  constexpr int SE = 0, SO = SD - 1;
  FA_SLOAD(SE, 0); asm volatile("s_waitcnt vmcnt(0)" ::: "memory"); FA_SWRITE(0, SE); __syncthreads();
  qkt<DQK>(pA0, pA1, K_lds, qr, r32, hi); FA_EXP(pA0);
  FA_SLOAD(SO, KVBLK); if (2 < NT) FA_SLOAD(SE, 2 * KVBLK);
  FA_SWRITE(1, SO); __syncthreads();
  __builtin_amdgcn_s_waitcnt(0x0F70);
  int bP = 0, bK = 1, bN = 2;
#define FA_ROT() do { const int t_ = bP; bP = bK; bK = bN; bN = t_; } while (0)
  f32x4 cvv[8]; CvtJob cvj; bool cvp = false; int cvt3 = 0;
  for (int j = 1; j + 1 < NT; j += 2) {
    if constexpr (CVT) {
      if (cvp) { cvt_store(cvj, wid, lane, cvv); cvp = false; }
      if (cvt3 == 0 && cv0 < cv1) { cvj = cvt_decode(cva, cvws, cv0); cvt_load(cvj, wid, lane, cvv); cvp = true; ++cv0; }
      cvt3 = cvt3 + 1 >= cvper ? 0 : cvt3 + 1;
    }
    FA_SBAR(); qkt<DQK>(pB0, pB1, K_lds + bK * SHM_K, qr, r32, hi);
    FA_EXP(pA1); packP(pA0, pA1, pa0, pa1, pa2, pa3); FA_SBAR();
    FA_SLOAD(SO, (j + 2) * KVBLK); FA_SBAR();
    pv_sum<NB>(o, vb0 + bP * SHM_V, pa0, pa1, pa2, pa3); FA_EXP(pB0);
    FA_SWRITE(bN, SE);
    __syncthreads(); FA_ROT();
    if (j + 3 < NT) FA_SLOAD(SE, (j + 3) * KVBLK);
    FA_SBAR(); qkt<DQK>(pA0, pA1, K_lds + bK * SHM_K, qr, r32, hi);
    FA_EXP(pB1); packP(pB0, pB1, pa0, pa1, pa2, pa3); FA_SBAR();
    pv_sum<NB>(o, vb0 + bP * SHM_V, pa0, pa1, pa2, pa3); FA_EXP(pA0);
    FA_SWRITE(bN, SO);
    __syncthreads(); FA_ROT();
  }
  if constexpr (CVT) { if (cvp) cvt_store(cvj, wid, lane, cvv); }
  FA_SBAR(); qkt<DQK>(pB0, pB1, K_lds + bK * SHM_K, qr, r32, hi);
  FA_EXP(pA1); packP(pA0, pA1, pa0, pa1, pa2, pa3); FA_SBAR();
  pv_sum<NB>(o, vb0 + bP * SHM_V, pa0, pa1, pa2, pa3); FA_EXP(pB0);
  FA_EXP(pB1); packP(pB0, pB1, pa0, pa1, pa2, pa3); FA_SBAR();
  pv_sum<NB>(o, vb0 + bK * SHM_V, pa0, pa1, pa2, pa3);
#undef FA_ROT
  bf16* Ow = Ob + (long)(wid * QBLK) * ldo;
#pragma unroll
  for (int r = 0; r < 16; ++r) { const int orow = crow(r, hi); const float rl = __builtin_amdgcn_rcpf(o[NB][r]);
#pragma unroll
    for (int d0 = 0; d0 < NB; ++d0) Ow[(long)orow * ldo + d0 * 32 + r32] = f2bf(o[d0][r] * rl); }
  __syncthreads();
#undef FA_SLOAD
#undef FA_SWRITE
#undef FA_EXP
}
template <int DQK, int DV>
__device__ __forceinline__ void attn_unit_single(const bf16* __restrict__ Qb, const int ldq, const bf16* __restrict__ Kh, const int ldk, const bf16* __restrict__ Vh, const int ldv,
                                                 bf16* __restrict__ Ob, const int ldo, const int seq, const float scale, LAS char* lds) {
  constexpr int NB = DV / 32, NQ = DQK / 16, SHM_V = KVBLK * DV * 2, SHM_K = KVBLK * DQK * 2;
  constexpr int CPK = DQK / 8, CPV = DV / 8, PK = KVBLK * CPK / 512, PV = KVBLK * CPV / 512;
  static_assert(KVBLK * CPK % 512 == 0 && KVBLK * CPV % 512 == 0, "tile chunks must divide over 512 threads");
  const int tid = opq_tid(), wid = tid >> 6, lane = tid & 63, r32 = lane & 31, hi = lane >> 5;
  LAS char* V_lds = lds; LAS char* K_lds = lds + 2 * SHM_V;
  LAS float* wsf = (LAS float*)(lds + 2 * SHM_V + 2 * SHM_K) + wid * 64; LAS float* li_l = wsf; LAS float* al_l = wsf + 32;
  const float C = scale * 1.4426950408889634f, thr_raw = 8.f / scale;
  float m_reg = -1e30f, l_reg = 0; f32x16 o[NB]; bf16x8 qr[NQ];
#pragma unroll
  for (int d = 0; d < NB; ++d) o[d] = f32x16{};
  const bf16* Qw = Qb + (long)(wid * QBLK + r32) * ldq + hi * 8;
#pragma unroll
  for (int d0 = 0; d0 < NQ; ++d0) qr[d0] = *reinterpret_cast<const bf16x8*>(Qw + d0 * 16);
  const int vb0 = (int)(uintptr_t)V_lds + v_rd_base(lane);
  bf16x8 sk[PK], sv[PV];
#define FA_SLOAD(k0) do { int t_ = tid; asm volatile("" : "+v"(t_)); \
    _Pragma("unroll") for (int p = 0; p < PV; ++p) { const int idx = t_ + 512 * p; sv[p] = *reinterpret_cast<const bf16x8*>(&Vh[(long)((k0) + idx / CPV) * ldv + (idx % CPV) * 8]); } \
    _Pragma("unroll") for (int p = 0; p < PK; ++p) { const int idx = t_ + 512 * p; sk[p] = *reinterpret_cast<const bf16x8*>(&Kh[(long)((k0) + idx / CPK) * ldk + (idx % CPK) * 8]); } } while (0)
#define FA_SWRITE(b) do { int t_ = tid; asm volatile("" : "+v"(t_)); \
    _Pragma("unroll") for (int p = 0; p < PV; ++p) { const int idx = t_ + 512 * p; *(LAS bf16x8*)(V_lds + (b) * SHM_V + v_st<NB>(idx / CPV, (idx % CPV) * 8)) = sv[p]; } \
    _Pragma("unroll") for (int p = 0; p < PK; ++p) { const int idx = t_ + 512 * p; *(LAS bf16x8*)(K_lds + (b) * SHM_K + kswz<DQK>(idx / CPK, (idx % CPK) * 16)) = sk[p]; } } while (0)
  f32x16 p0, p1; float mn, al; bf16x8 pa0, pa1, pa2, pa3; const int NT = seq / KVBLK;
  FA_SLOAD(0); FA_SWRITE(0); __syncthreads();
  FA_SLOAD(KVBLK);
  for (int j = 0; j < NT; ++j) {
    const int b = j & 1;
    FA_SBAR(); qkt<DQK>(p0, p1, K_lds + b * SHM_K, qr, r32, hi);
    partialSM(p0, p1, m_reg, mn, al, C, thr_raw);
    if (__any(al < 1.f)) { if (hi == 0) al_l[r32] = al; asm volatile("s_waitcnt lgkmcnt(0)" ::: "memory");
#pragma unroll
      for (int d = 0; d < NB; ++d)
#pragma unroll
        for (int r = 0; r < 16; ++r) o[d][r] *= al_l[crow(r, hi)]; }
    finishSM(p0, p1, al, l_reg, pa0, pa1, pa2, pa3); FA_SBAR();
    if (j + 1 < NT) FA_SWRITE(b ^ 1);
    FA_SBAR();
    pv_all<NB>(o, vb0 + b * SHM_V, pa0, pa1, pa2, pa3);
    __syncthreads();
    if (j + 2 < NT) FA_SLOAD((j + 2) * KVBLK);
  }
  if (hi == 0) li_l[r32] = l_reg; asm volatile("s_waitcnt lgkmcnt(0)" ::: "memory");
  float rli[16];
#pragma unroll
  for (int r = 0; r < 16; ++r) rli[r] = __builtin_amdgcn_rcpf(li_l[crow(r, hi)]);
  bf16* Ow = Ob + (long)(wid * QBLK) * ldo;
#pragma unroll
  for (int r = 0; r < 16; ++r) { const int orow = crow(r, hi);
#pragma unroll
    for (int d0 = 0; d0 < NB; ++d0) Ow[(long)orow * ldo + d0 * 32 + r32] = f2bf(o[d0][r] * rli[r]); }
  __syncthreads();
#undef FA_SLOAD
#undef FA_SWRITE
}
template <int DQK, int DV, int NQL>
__device__ __forceinline__ void attn_unit_fixed_ql(const bf16* __restrict__ Qb, const int ldq, const bf16* __restrict__ Kh, const int ldk, const bf16* __restrict__ Vh, const int ldv,
                                                   bf16* __restrict__ Ob, const int ldo, const int seq, LAS char* lds, const Args& cva, unsigned char* cvws, int cv0, const int cv1, const int cvper) {
  constexpr int NB = DV / 32, NQ = DQK / 16, NQR = NQ - NQL, SHM_V = KVBLK * DV * 2, SHM_K = KVBLK * DQK * 2;
  constexpr int CPK = DQK / 8, CPV = DV / 8, PK = KVBLK * CPK / 512, PV = KVBLK * CPV / 512;
  static_assert(KVBLK * CPK % 512 == 0 && KVBLK * CPV % 512 == 0 && NQL == 4, "tile chunks must divide over 512 threads; 4 LDS fragments = 128-byte rows");
  const int tid = opq_tid(), wid = tid >> 6, lane = tid & 63, r32 = lane & 31, hi = lane >> 5;
  LAS char* V_lds = lds; LAS char* K_lds = lds + 2 * SHM_V;
  LAS float* li_l = (LAS float*)(lds + 2 * SHM_V + 2 * SHM_K) + wid * 64;
  LAS char* Qls = lds + 2 * SHM_V + 2 * SHM_K + 2048 + wid * 4096;
  float l_reg = 0.f; f32x16 o[NB]; bf16x8 qr[NQR];
#pragma unroll
  for (int d = 0; d < NB; ++d) o[d] = f32x16{};
  const bf16* Qw = Qb + (long)(wid * QBLK + r32) * ldq + hi * 8;
#pragma unroll
  for (int d0 = 0; d0 < NQR; ++d0) qr[d0] = *reinterpret_cast<const bf16x8*>(Qw + d0 * 16);
#pragma unroll
  for (int i = 0; i < NQL; ++i) *(LAS bf16x8*)(Qls + kswz<64>(r32, i * 32 + hi * 16)) = *reinterpret_cast<const bf16x8*>(Qw + (NQR + i) * 16);
  int kq[4];
#pragma unroll
  for (int i = 0; i < 4; ++i) kq[i] = r32 * (2 * DQK) + ((32 * i + 16 * hi) ^ (((r32 >> 1) & 7) << 4));
  static_assert((2 * DQK) % 128 == 0, "K rows are whole 128-byte groups");
  const int vb0 = (int)(uintptr_t)V_lds + v_rd_base(lane);
  bf16x8 sk[PK], sv[PV];
#define FA_SLOAD(k0) do { int t_ = tid; asm volatile("" : "+v"(t_)); \
    _Pragma("unroll") for (int p = 0; p < PV; ++p) { const int idx = t_ + 512 * p; sv[p] = *reinterpret_cast<const bf16x8*>(&Vh[(long)((k0) + idx / CPV) * ldv + (idx % CPV) * 8]); } \
    _Pragma("unroll") for (int p = 0; p < PK; ++p) { const int idx = t_ + 512 * p; sk[p] = *reinterpret_cast<const bf16x8*>(&Kh[(long)((k0) + idx / CPK) * ldk + (idx % CPK) * 8]); } } while (0)
#define FA_SWRITE(b) do { int t_ = tid; asm volatile("" : "+v"(t_)); \
    _Pragma("unroll") for (int p = 0; p < PV; ++p) { const int idx = t_ + 512 * p; *(LAS bf16x8*)(V_lds + (b) * SHM_V + v_st<NB>(idx / CPV, (idx % CPV) * 8)) = sv[p]; } \
    _Pragma("unroll") for (int p = 0; p < PK; ++p) { const int idx = t_ + 512 * p; *(LAS bf16x8*)(K_lds + (b) * SHM_K + kswz<DQK>(idx / CPK, (idx % CPK) * 16)) = sk[p]; } } while (0)
  f32x16 p0, p1; bf16x8 pa0, pa1, pa2, pa3; const int NT = seq / KVBLK;
  FA_SLOAD(0); FA_SWRITE(0); __syncthreads();
  FA_SLOAD(KVBLK);
  f32x4 cvv[8]; CvtJob cvj; bool cvp = false; int cvt3 = 0; const int widu = __builtin_amdgcn_readfirstlane(wid);
  for (int j = 0; j < NT; ++j) {
    if (cvp && cvt3 == 0) { cvt_store(cvj, widu, lane, cvv); cvp = false; }
    if (cvt3 == 0 && cv0 < cv1) { cvj = cvt_decode(cva, cvws, cv0); cvt_load(cvj, widu, lane, cvv); cvp = true; ++cv0; }
    cvt3 = cvt3 + 1 >= cvper ? 0 : cvt3 + 1;
    const int b = j & 1; const LAS char* Ks = K_lds + b * SHM_K;
    FA_SBAR(); p0 = f32x16{}; p1 = f32x16{};
#pragma unroll
    for (int d0 = 0; d0 < NQ; ++d0) {
      const bf16x8 b0 = *(const LAS bf16x8*)(Ks + kq[d0 & 3] + (d0 >> 2) * 128); const bf16x8 b1 = *(const LAS bf16x8*)(Ks + kq[d0 & 3] + (d0 >> 2) * 128 + 32 * 2 * DQK);
      bf16x8 qf; if (d0 < NQR) qf = qr[d0 < NQR ? d0 : 0]; else qf = *(const LAS bf16x8*)(Qls + kswz<64>(r32, (d0 - NQR) * 32 + hi * 16));
      p0 = __builtin_amdgcn_mfma_f32_32x32x16_bf16(b0, qf, p0, 0, 0, 0); p1 = __builtin_amdgcn_mfma_f32_32x32x16_bf16(b1, qf, p1, 0, 0, 0); }
#pragma unroll
    for (int r = 0; r < 16; ++r) { p0[r] = __builtin_amdgcn_exp2f(p0[r]); l_reg += p0[r]; }
#pragma unroll
    for (int r = 0; r < 16; ++r) { p1[r] = __builtin_amdgcn_exp2f(p1[r]); l_reg += p1[r]; }
    packP(p0, p1, pa0, pa1, pa2, pa3); FA_SBAR();
    if (j + 1 < NT) FA_SWRITE(b ^ 1);
    FA_SBAR();
    pv_all<NB>(o, vb0 + b * SHM_V, pa0, pa1, pa2, pa3);
    __syncthreads();
    if (j + 2 < NT) FA_SLOAD((j + 2) * KVBLK);
  }
  if (cvp) cvt_store(cvj, widu, lane, cvv);
  { auto rr = __builtin_amdgcn_permlane32_swap(__float_as_uint(l_reg), __float_as_uint(l_reg), false, false); l_reg = __uint_as_float(rr[0]) + __uint_as_float(rr[1]); }
  if (hi == 0) li_l[r32] = l_reg; asm volatile("s_waitcnt lgkmcnt(0)" ::: "memory");
  bf16* Ow = Ob + (long)(wid * QBLK) * ldo;
#pragma unroll
  for (int r = 0; r < 16; ++r) { const int orow = crow(r, hi); const float rl = __builtin_amdgcn_rcpf(li_l[orow]);
#pragma unroll
    for (int d0 = 0; d0 < NB; ++d0) Ow[(long)orow * ldo + d0 * 32 + r32] = f2bf(o[d0][r] * rl); }
  __syncthreads();
#undef FA_SLOAD
#undef FA_SWRITE
}
}


__device__ __forceinline__ void ph_modulate(const Frame& F, const float* X, const float* shift, const float* scale, bf16* U) {
    for (int t = F.gw; t < S; t += F.ngw) {
        int j0 = 4 * F.lane; asm volatile("" : "+v"(j0));
#pragma unroll
        for (int i = 0; i < 8; ++i) { const int j = j0 + 256 * i;
            const f32x4 x = *(const f32x4*)(X + (size_t)t * D + j), sc = *(const f32x4*)(scale + j), sh = *(const f32x4*)(shift + j);
            v2u o; o.x = (unsigned)f2bf(x.x * (1.f + sc.x) + sh.x) | ((unsigned)f2bf(x.y * (1.f + sc.y) + sh.y) << 16);
            o.y = (unsigned)f2bf(x.z * (1.f + sc.z) + sh.z) | ((unsigned)f2bf(x.w * (1.f + sc.w) + sh.w) << 16);
            *(v2u*)(U + (size_t)t * D + j) = o; }
    }
}
__device__ __forceinline__ void rope_cs(int t, int lane, float& cs, float& sn) {
    const int i = lane & 15; const float pos = (float)((lane < 32) ? (t >> 6) : (t & 63));
    const float invf = exp2f(-(float)i * (13.287712379549449f / 16.f));
    const float ang = pos * invf; cs = cosf(ang); sn = sinf(ang);
}
__device__ __forceinline__ float rope_lane(float y, int lane, float cs, float sn) { const float p = __shfl_xor(y, 16); return (lane & 16) ? (y * cs + p * sn) : (y * cs - p * sn); }

__device__ __forceinline__ void ph_rope_table(const Frame& F) {
    float* RT = (float*)(F.ws + O_ROPE);
    for (int t = F.gw; t < S; t += F.ngw) { if (F.lane < 32) { float cs, sn; rope_cs(t, F.lane < 16 ? F.lane : F.lane + 16, cs, sn);
        RT[(size_t)t * 64 + (F.lane >> 4) * 32 + (F.lane & 15)] = cs; RT[(size_t)t * 64 + (F.lane >> 4) * 32 + 16 + (F.lane & 15)] = sn; } }
}
__device__ __forceinline__ f32x4 ld4bf(const bf16* p) { const v2u w = *(const v2u*)p; return (f32x4){__uint_as_float(w.x << 16), __uint_as_float(w.x & 0xffff0000u), __uint_as_float(w.y << 16), __uint_as_float(w.y & 0xffff0000u)}; }
__device__ __forceinline__ float grp16_sum(float v) { v += __shfl_xor(v, 1); v += __shfl_xor(v, 2); v += __shfl_xor(v, 4); v += __shfl_xor(v, 8); return v; }
__device__ __forceinline__ float dot4(f32x4 x) { return (x.x * x.x + x.y * x.y) + (x.z * x.z + x.w * x.w); }
__device__ __forceinline__ f32x4 rope4(f32x4 y, int lane, f32x4 cs, f32x4 sn) {
    f32x4 p; p.x = __shfl_xor(y.x, 4); p.y = __shfl_xor(y.y, 4); p.z = __shfl_xor(y.z, 4); p.w = __shfl_xor(y.w, 4);
    return (lane & 4) ? (y * cs + p * sn) : (y * cs - p * sn);
}
__device__ __forceinline__ v2u pack4(f32x4 v) { v2u o; o.x = pg8::cvt_pk_bf16(v.x, v.y); o.y = pg8::cvt_pk_bf16(v.z, v.w); return o; }
__device__ __forceinline__ void ph_post(const Frame& F, const Args& a, int l) {
    const float* gqn = LIN(3); const float* gkn = LIN(4); const float* mqn = LIN(5); const float* mkvn = LIN(7);
    const float* cw = LIN(9);
    const bf16* RAW = (const bf16*)(F.ws + O_RAW); const float* RT = (const float*)(F.ws + O_ROPE);
    bf16* QG = (bf16*)(F.ws + O_QG); bf16* KG = (bf16*)(F.ws + O_KG); bf16* VG = (bf16*)(F.ws + O_VG);
    bf16* CQ = (bf16*)(F.ws + O_CQ); bf16* CKV = (bf16*)(F.ws + O_CKV); bf16* KM = (bf16*)(F.ws + O_KM);
    bf16* MQ = (bf16*)(F.ws + O_MQ); bf16* MK = (bf16*)(F.ws + O_MK); bf16* MV = (bf16*)(F.ws + O_MV);
    const int lane = F.lane;
    const f32x4 gq4 = *(const f32x4*)(gqn + 4 * (lane & 15)), gk4 = *(const f32x4*)(gkn + 4 * (lane & 15));
    for (int t = F.gw; t < S; t += F.ngw) {
        int lo_ = 4 * lane; asm volatile("" : "+v"(lo_));
        const bf16* raw = RAW + (size_t)t * DINP + lo_;
        f32x4 v[16], xm[5], xp[5];
#pragma unroll
        for (int i = 0; i < 16; ++i) v[i] = ld4bf(raw + 256 * i);
        const bool hm = t > 0, hp = t < S - 1; const f32x4 z4 = {0.f, 0.f, 0.f, 0.f};
#pragma unroll
        for (int i = 0; i < 5; ++i) { xm[i] = hm ? ld4bf(raw + 256 * (9 + i) - DINP) : z4; xp[i] = hp ? ld4bf(raw + 256 * (9 + i) + DINP) : z4; }
        const float* rt = RT + (size_t)t * 64 + ((lane >> 3) & 1) * 32 + 4 * (lane & 3);
        const f32x4 cs = *(const f32x4*)rt, sn = *(const f32x4*)(rt + 16);
#pragma unroll
        for (int i = 0; i < 4; ++i) { const float r = 1.f / sqrtf(grp16_sum(dot4(v[i])) * (1.f / 64.f) + 1e-6f);
            *(v2u*)(QG + (size_t)t * 1024 + 256 * i + lo_) = pack4(rope4(v[i] * r * gq4, lane, cs, sn) * GQA_QSCALE); }
        { const float r = 1.f / sqrtf(grp16_sum(dot4(v[4])) * (1.f / 64.f) + 1e-6f);
          *(v2u*)(KG + (size_t)t * 256 + lo_) = pack4(rope4(v[4] * r * gk4, lane, cs, sn)); *(v2u*)(VG + (size_t)t * 256 + lo_) = pack4(v[5]); }
        { const float r = 1.f / sqrtf(wave_sum(dot4(v[6]) + dot4(v[7])) * (1.f / 512.f) + 1e-6f);
          *(v2u*)(CQ + (size_t)t * 512 + lo_) = pack4(v[6] * r * *(const f32x4*)(mqn + lo_)); *(v2u*)(CQ + (size_t)t * 512 + 256 + lo_) = pack4(v[7] * r * *(const f32x4*)(mqn + 256 + lo_)); }
        { const float r = 1.f / sqrtf(wave_sum(dot4(v[8])) * (1.f / 256.f) + 1e-6f);
          *(v2u*)(CKV + (size_t)t * 256 + lo_) = pack4(v[8] * r * *(const f32x4*)(mkvn + lo_)); }
        { const v2u o = pack4(rope4(v[9], lane, cs, sn));
          if (lane < 16) {
#pragma unroll
              for (int h = 0; h < 4; ++h) *(v2u*)(KM + (size_t)t * 768 + h * 192 + 128 + lo_) = o; } }
#pragma unroll
        for (int i = 0; i < 5; ++i) { const int m = 256 * (9 + i) + lo_ - C_MQ;
            if (m >= 0 && m < 1024) { const f32x4 x = *(const f32x4*)(cw + m) * xm[i] + *(const f32x4*)(cw + 1024 + m) * v[9 + i] + *(const f32x4*)(cw + 2048 + m) * xp[i];
                const f32x4 sv = {siluf(x.x), siluf(x.y), siluf(x.z), siluf(x.w)};
                if (m < 512) *(v2u*)(MQ + (size_t)t * 512 + m) = pack4(sv); else *(v2u*)(MK + (size_t)t * 512 + m - 512) = pack4(sv * 0.08838834764831845f); } }
#pragma unroll
        for (int i = 13; i < 16; ++i) { const int m = 256 * i + lo_ - C_MV; if (m >= 0 && m < 512) *(v2u*)(MV + (size_t)t * 512 + m) = pack4(v[i]); }
    }
}
__device__ __forceinline__ void ph_mlapost(const Frame& F, const int layer) {
    const bf16* RQ = (const bf16*)(F.ws + O_RAWQ); const bf16* RKV = (const bf16*)(F.ws + O_RAWKV);
    bf16* QM = (bf16*)(F.ws + O_QM); bf16* KM = (bf16*)(F.ws + O_KM); bf16* VM = (bf16*)(F.ws + O_VM);
    const int lane = F.lane, lo = 4 * lane;
    float mq[4] = {0.f, 0.f, 0.f, 0.f}, mk[4] = {0.f, 0.f, 0.f, 0.f};
    for (int t = F.gw; t < S; t += F.ngw) {
        const float* rt = (const float*)(F.ws + O_ROPE) + (size_t)t * 64 + ((lane >> 3) & 1) * 32 + 4 * (lane & 3);
        const f32x4 cs = *(const f32x4*)rt, sn = *(const f32x4*)(rt + 16);
        const bf16* rq = RQ + (size_t)t * 768 + lo; const bf16* rkv = RKV + (size_t)t * 1024 + lo;
        f32x4 q[3], kv[4];
#pragma unroll
        for (int i = 0; i < 3; ++i) q[i] = ld4bf(rq + 256 * i) * MLA_QSCALE;
#pragma unroll
        for (int i = 0; i < 4; ++i) kv[i] = ld4bf(rkv + 256 * i);
        const f32x4 kr = (lane < 16) ? ld4bf(KM + (size_t)t * 768 + 128 + lo) : (f32x4){0.f, 0.f, 0.f, 0.f};
        const float krn2 = wave_sum(dot4(kr));
        const int g16 = lane >> 4;
        v2u qo[3];
#pragma unroll
        for (int i = 0; i < 3; ++i) { const f32x4 r = rope4(q[i], lane, cs, sn);
            const bool isr = (i == 0 && g16 == 2) || (i == 1 && g16 == 1) || (i == 2 && (g16 == 0 || g16 == 3));
            qo[i] = pack4(isr ? r : q[i]); *(v2u*)(QM + (size_t)t * 768 + 256 * i + lo) = qo[i]; }
        float qs[3];
#pragma unroll
        for (int i = 0; i < 3; ++i) { const f32x4 b = {__uint_as_float(qo[i].x << 16), __uint_as_float(qo[i].x & 0xffff0000u), __uint_as_float(qo[i].y << 16), __uint_as_float(qo[i].y & 0xffff0000u)}; qs[i] = dot4(b); }
        const float h0 = wave_sum(g16 < 3 ? qs[0] : 0.f), h1 = wave_sum((g16 == 3 ? qs[0] : 0.f) + (g16 < 2 ? qs[1] : 0.f));
        const float h2 = wave_sum((g16 >= 2 ? qs[1] : 0.f) + (g16 == 0 ? qs[2] : 0.f)), h3 = wave_sum(g16 >= 1 ? qs[2] : 0.f);
        mq[0] = fmaxf(mq[0], h0); mq[1] = fmaxf(mq[1], h1); mq[2] = fmaxf(mq[2], h2); mq[3] = fmaxf(mq[3], h3);
#pragma unroll
        for (int h = 0; h < 4; ++h) { const v2u w = pack4(kv[h]);
            if (lane < 32) *(v2u*)(KM + (size_t)t * 768 + h * 192 + lo) = w; else *(v2u*)(VM + (size_t)t * 512 + h * 128 + lo - 128) = w;
            const f32x4 b = {__uint_as_float(w.x << 16), __uint_as_float(w.x & 0xffff0000u), __uint_as_float(w.y << 16), __uint_as_float(w.y & 0xffff0000u)};
            mk[h] = fmaxf(mk[h], wave_sum(lane < 32 ? dot4(b) : 0.f) + krn2); }
    }
    LAS float* red = (LAS float*)F.lds;
    if (lane == 0) {
#pragma unroll
        for (int h = 0; h < 4; ++h) { red[F.wave * 8 + 2 * h] = mq[h]; red[F.wave * 8 + 2 * h + 1] = mk[h]; } }
    __syncthreads();
    if (F.tid < 8) { float m = red[F.tid];
#pragma unroll
        for (int w = 1; w < NWAVES; ++w) m = fmaxf(m, red[w * 8 + F.tid]);
        ((float*)(F.ws + O_MLAB))[F.bid * 8 + F.tid] = m; }
    __syncthreads();
}
__device__ __forceinline__ bool mla_bounds_ok(const Frame& F) {
    const float* MB = (const float*)(F.ws + O_MLAB); float m[8];
#pragma unroll
    for (int i = 0; i < 8; ++i) m[i] = 0.f;
    for (int b = F.lane; b < F.nblk; b += 64) {
#pragma unroll
        for (int i = 0; i < 8; ++i) m[i] = fmaxf(m[i], MB[b * 8 + i]); }
    bool ok = true;
#pragma unroll
    for (int h = 0; h < 4; ++h) ok = ok && (sqrtf(wave_max(m[2 * h])) * sqrtf(wave_max(m[2 * h + 1])) < 80.f);
    return __builtin_amdgcn_readfirstlane((int)ok) != 0;
}
template <bool MLAFIX>
__device__ __forceinline__ void ph_fattn(const Frame& F, const Args& a, const int layer, const float* gqn, const float* gkn) {
    const bf16* QG = (const bf16*)(F.ws + O_QG); const bf16* KG = (const bf16*)(F.ws + O_KG); const bf16* VG = (const bf16*)(F.ws + O_VG);
    const bf16* QM = (const bf16*)(F.ws + O_QM); const bf16* KM = (const bf16*)(F.ws + O_KM); const bf16* VM = (const bf16*)(F.ws + O_VM);
    bf16* MIX = (bf16*)(F.ws + O_MIX);
    LAS char* lds = (LAS char*)F.lds;
    const int c = F.bid;
    if (MLAFIX && F.nblk >= 128) {
        if (c < 128) { const int h = c & 3, qb = c >> 2;
            const int m0 = layer ? CVT_L1 + c * CVT_M1 : CVT_EARLY + c * CVT_M0; int m1 = m0 + (layer ? CVT_M1 : CVT_M0); if (m1 > CVT_ITEMS) m1 = CVT_ITEMS;
            fa::attn_unit_fixed_ql<192, 128, 4>(QM + (size_t)qb * 256 * 768 + h * 192, 768, KM + h * 192, 768, VM + h * 128, 512, MIX + (size_t)qb * 256 * D + 1024 + h * 128, D, S, lds, a, F.ws, m0 < m1 ? m0 : m1, m1, layer ? 6 : 4); }
    } else {
        for (int u = c; u < 128; u += F.nblk) { const int h = u & 3, qb = u >> 2;
            fa::attn_unit_single<192, 128>(QM + (size_t)qb * 256 * 768 + h * 192, 768, KM + h * 192, 768, VM + h * 128, 512, MIX + (size_t)qb * 256 * D + 1024 + h * 128, D, S, 0.6931471805599453f, lds); }
    }
    float mq = 0.f, mk = 0.f;
    for (int i = 0; i < 64; ++i) { mq = fmaxf(mq, fabsf(gqn[i])); mk = fmaxf(mk, fabsf(gkn[i])); }
    const float bound2 = 8.f * mq * mk * 1.4426950408889634f * 1.02f;
    const bool fixed_ok = bound2 < 80.f;
    const bool bal = F.nblk == 256; const int j = c >> 2;
    const int nw = bal ? (j < 32 ? 1 : 3) : (512 - c + F.nblk - 1) / F.nblk;
    for (int k = 0; k < nw; ++k) {
        const int u = bal ? ((j < 32 ? j : 32 + 3 * (j - 32) + k) * 4 + (c & 3)) : c + k * F.nblk;
        const int kvh = u & 3, w = u >> 2, h = kvh * 4 + (w & 3), qb = w >> 2;
        const bool mlacv = MLAFIX && F.nblk >= 128;
        const int gper = mlacv ? (layer ? CVT_G1 : CVT_G0) : (layer ? CVT_U1 : CVT_U0), gbase = (layer ? CVT_L1 : CVT_EARLY) + (mlacv ? 128 * (layer ? CVT_M1 : CVT_M0) : 0);
        int cv0 = gbase + u * gper, cv1 = cv0 + gper; if (cv1 > CVT_ITEMS) cv1 = CVT_ITEMS; if (cv0 > cv1) cv0 = cv1;
        const int cvper = mlacv ? 3 : (layer ? 3 : 2);
        if (fixed_ok) fa::attn_unit_fixed<64, 64, 2, true>(QG + (size_t)qb * 256 * 1024 + h * 64, 1024, KG + kvh * 64, 256, VG + kvh * 64, 256, MIX + (size_t)qb * 256 * D + h * 64, D, S, lds, a, F.ws, cv0, cv1, cvper);
        else fa::attn_unit<64, 64, 2, true>(QG + (size_t)qb * 256 * 1024 + h * 64, 1024, KG + kvh * 64, 256, VG + kvh * 64, 256, MIX + (size_t)qb * 256 * D + h * 64, D, S, 0.6931471805599453f, lds, a, F.ws, cv0, cv1, cvper); }
}
namespace ml {
using fa::bf16x8; using fa::f32x16; using fa::u32x4; using fa::crow; using fa::cvtpk;
typedef short v4i16_t __attribute__((ext_vector_type(4)));
__device__ __forceinline__ bf16x8 trfrag(const LAS char* p, int d0, int ks) {
    const v4i16_t lo = __builtin_amdgcn_ds_read_tr16_b64_v4i16((LAS v4i16_t*)(p + ((2 * ks) * 4 + d0) * 512));
    const v4i16_t hi = __builtin_amdgcn_ds_read_tr16_b64_v4i16((LAS v4i16_t*)(p + ((2 * ks + 1) * 4 + d0) * 512));
    return (bf16x8){lo[0], lo[1], lo[2], lo[3], hi[0], hi[1], hi[2], hi[3]};
}
__device__ __forceinline__ int img_off(int row, int col) { return (row >> 6) * 16384 + fa::v_st<4>(row & 63, col); }
__device__ __forceinline__ bf16x8 pack8(const float* v) { u32x4 w = {cvtpk(v[0], v[1]), cvtpk(v[2], v[3]), cvtpk(v[4], v[5]), cvtpk(v[6], v[7])}; return __builtin_bit_cast(bf16x8, w); }
__device__ __forceinline__ float hsum2(float v) { auto rr = __builtin_amdgcn_permlane32_swap(__float_as_uint(v), __float_as_uint(v), false, false); return __uint_as_float(rr[0]) + __uint_as_float(rr[1]); }
}

__device__ __forceinline__ void ph_m0_fast(const Frame& F, const float* gb) {
    const float* GT = (const float*)(F.ws + O_GATES); float* GI = (float*)(F.ws + O_GI);
    float* BC = (float*)(F.ws + O_BC); float* WW = (float*)(F.ws + O_WW); float* PM = (float*)(F.ws + O_PM);
    float* GC = (float*)(F.ws + O_CHS); float* MC = GC + 512;
    const int lane = F.lane;
    for (int it = F.gw; it < 512; it += F.ngw) {
        const int dh = it >> 6, cl = it & 63, dir = dh >> 2; const size_t rb = (size_t)dh * S;
        const int tp0 = physt(dir, cl * CH + 2 * lane), tp1 = physt(dir, cl * CH + 2 * lane + 1);
        const int h = dh & 3, ci = (2 * dir) * 4 + h, cf = ci + 4; const float bi = gb[ci], bff = gb[cf];
        const float li0 = GT[(size_t)tp0 * 16 + ci] + bi, li1 = GT[(size_t)tp1 * 16 + ci] + bi;
        const float lf0 = logsigmoidf(GT[(size_t)tp0 * 16 + cf] + bff), lf1 = logsigmoidf(GT[(size_t)tp1 * 16 + cf] + bff);
        GI[rb + tp0] = li0; GI[rb + tp1] = li1;
        float inc = lf0 + lf1;
#pragma unroll
        for (int o = 1; o < 64; o <<= 1) { const float v = __shfl_up(inc, o); if (lane >= o) inc += v; }
        const float b1 = inc, b0 = inc - lf1; const float g = __shfl(inc, 63);
        const float x0 = li0 - b0, x1 = li1 - b1; float mxs = fmaxf(x0, x1);
#pragma unroll
        for (int o = 1; o < 64; o <<= 1) { const float v = __shfl_up(mxs, o); if (lane >= o) mxs = fmaxf(mxs, v); }
        float ex = __shfl_up(mxs, 1); if (lane == 0) ex = -INFINITY;
        const float pm0 = fmaxf(ex, x0), pm1 = fmaxf(pm0, x1);
        const float a0 = g - b0 + li0, a1 = g - b1 + li1; const float ml_ = wave_max(fmaxf(a0, a1));
        BC[rb + tp0] = b0; BC[rb + tp1] = b1; PM[rb + tp0] = pm0; PM[rb + tp1] = pm1; WW[rb + tp0] = expf(a0 - ml_); WW[rb + tp1] = expf(a1 - ml_);
        if (lane == 0) { GC[it] = g; MC[it] = ml_; }
    }
}
__device__ __forceinline__ void ph_m1_fast(const Frame& F) {
    const float* WW = (const float*)(F.ws + O_WW); const bf16* MK = (const bf16*)(F.ws + O_MK); const bf16* MV = (const bf16*)(F.ws + O_MV);
    float* KV = (float*)(F.ws + O_KV); float* KS = (float*)(F.ws + O_KS);
    LAS char* Vimg = (LAS char*)F.lds; LAS char* Kimg = Vimg + 32768;
    const int tid = F.tid, lane = F.lane, r32 = lane & 31, hi = lane >> 5, db = F.wave & 3, eh = F.wave >> 2;
    const int rdb = fa::v_rd_base(lane);
    const ml::bf16x8 ones = {0x3F80, 0x3F80, 0x3F80, 0x3F80, 0x3F80, 0x3F80, 0x3F80, 0x3F80};
    for (int u = F.bid; u < 256; u += F.nblk) {
        const int h = u & 3, co = u >> 2;
#pragma unroll
        for (int p = 0; p < 4; ++p) { const int idx = tid + 512 * p, row = idx >> 4, c8 = idx & 15;
            *(LAS ml::bf16x8*)(Vimg + ml::img_off(row, c8 * 8)) = *(const ml::bf16x8*)(MV + (size_t)(co * CH + row) * 512 + h * 128 + c8 * 8); }
        for (int dir = 0; dir < 2; ++dir) {
            const int dh = dir * 4 + h, cl = dir ? 63 - co : co;
#pragma unroll
            for (int p = 0; p < 4; ++p) { const int idx = tid + 512 * p, row = idx >> 4, c8 = idx & 15; const int tp = co * CH + row;
                const v4u kr = *(const v4u*)(MK + (size_t)tp * 512 + h * 128 + c8 * 8); const float w = WW[(size_t)dh * S + tp];
                float f[8] = {__uint_as_float(kr.x << 16) * w, __uint_as_float(kr.x & 0xffff0000u) * w, __uint_as_float(kr.y << 16) * w, __uint_as_float(kr.y & 0xffff0000u) * w,
                              __uint_as_float(kr.z << 16) * w, __uint_as_float(kr.z & 0xffff0000u) * w, __uint_as_float(kr.w << 16) * w, __uint_as_float(kr.w & 0xffff0000u) * w};
                *(LAS ml::bf16x8*)(Kimg + ml::img_off(row, c8 * 8)) = ml::pack8(f); }
            __syncthreads();
            ml::f32x16 acc0 = {}, acc1 = {}, accs = {};
#pragma unroll
            for (int kk = 0; kk < 8; ++kk) {
                const ml::bf16x8 af = ml::trfrag(Kimg + (kk >> 2) * 16384 + rdb, db, kk & 3);
                const ml::bf16x8 b0 = ml::trfrag(Vimg + (kk >> 2) * 16384 + rdb, 2 * eh, kk & 3), b1 = ml::trfrag(Vimg + (kk >> 2) * 16384 + rdb, 2 * eh + 1, kk & 3);
                acc0 = __builtin_amdgcn_mfma_f32_32x32x16_bf16(af, b0, acc0, 0, 0, 0);
                acc1 = __builtin_amdgcn_mfma_f32_32x32x16_bf16(af, b1, acc1, 0, 0, 0);
                accs = __builtin_amdgcn_mfma_f32_32x32x16_bf16(af, ones, accs, 0, 0, 0);
            }
            float* kvp = KV + ((size_t)(dh * 64 + cl) << 14);
#pragma unroll
            for (int r = 0; r < 16; ++r) { const int d = 32 * db + ml::crow(r, hi);
                kvp[d * 128 + 32 * (2 * eh) + r32] = acc0[r]; kvp[d * 128 + 32 * (2 * eh + 1) + r32] = acc1[r];
                if (eh == 0 && r32 == 0) KS[(size_t)(dh * 64 + cl) * 128 + d] = accs[r]; }
            __syncthreads();
        }
    }
}
__device__ __forceinline__ void ph_m3_fast(const Frame& F, const float* hn) {
    const float* GI = (const float*)(F.ws + O_GI); const float* BC = (const float*)(F.ws + O_BC); const float* PM = (const float*)(F.ws + O_PM);
    const float* MP = (const float*)(F.ws + O_CHS) + 1024; const bf16* MQ = (const bf16*)(F.ws + O_MQ); const bf16* MK = (const bf16*)(F.ws + O_MK); const bf16* MV = (const bf16*)(F.ws + O_MV);
    const float* KV = (const float*)(F.ws + O_KV); const float* KS = (const float*)(F.ws + O_KS); const bf16* RAW = (const bf16*)(F.ws + O_RAW);
    bf16* MIX = (bf16*)(F.ws + O_MIX);
    LAS char* Kimg = (LAS char*)F.lds; LAS char* Vimg = Kimg + 32768; LAS char* Cimg = Kimg + 65536;
    LAS float* bsT = (LAS float*)(Kimg + 98304); LAS float* nT = bsT + 128; LAS float* wsc = nT + 128 + F.wave * 64; LAS float* Hb = (LAS float*)Kimg;
    const int tid = F.tid, lane = F.lane, r32 = lane & 31, hi = lane >> 5, tb = F.wave & 3, eh = F.wave >> 2;
    const int rdb = fa::v_rd_base(lane);
    for (int u = F.bid; u < 256; u += F.nblk) {
        const int h = u & 3, co = u >> 2;
#pragma unroll
        for (int p = 0; p < 4; ++p) { const int idx = tid + 512 * p, row = idx >> 4, c8 = idx & 15; const size_t g = (size_t)(co * CH + row) * 512 + h * 128 + c8 * 8;
            *(LAS ml::bf16x8*)(Kimg + row * 256 + ((c8 * 16) ^ ((row & 7) << 4))) = *(const ml::bf16x8*)(MK + g);
            *(LAS ml::bf16x8*)(Vimg + ml::img_off(row, c8 * 8)) = *(const ml::bf16x8*)(MV + g); }
        const int tl = 32 * tb + r32; const size_t tpt = (size_t)co * CH + tl;
        const bf16* qbase = MQ + tpt * 512 + h * 128 + hi * 8;
        ml::f32x16 hs0 = {}, hs1 = {};
        for (int dir = 0; dir < 2; ++dir) {
            const int dh = dir * 4 + h, cl = dir ? 63 - co : co;
            __syncthreads();
            const float* kvp = KV + ((size_t)(dh * 64 + cl) << 14);
#pragma unroll
            for (int p = 0; p < 4; ++p) { const int idx = tid + 512 * p, row = idx >> 4, c8 = idx & 15;
                const f32x4 c0 = *(const f32x4*)(kvp + row * 128 + c8 * 8), c1 = *(const f32x4*)(kvp + row * 128 + c8 * 8 + 4);
                const float f[8] = {c0.x, c0.y, c0.z, c0.w, c1.x, c1.y, c1.z, c1.w};
                *(LAS ml::bf16x8*)(Cimg + ml::img_off(row, c8 * 8)) = ml::pack8(f); }
            if (tid < 128) { const size_t gi = (size_t)dh * S + (size_t)co * CH + tid; bsT[tid] = (GI[gi] - BC[gi]) * 1.4426950408889634f  ; nT[tid] = KS[(size_t)(dh * 64 + cl) * 128 + tid]; }
            const float Bt = BC[(size_t)dh * S + tpt], mp = MP[dh * 64 + cl], mx = fmaxf(mp, PM[(size_t)dh * S + tpt]);
            const float btl = -mx * 1.4426950408889634f, iw = expf(mp - mx), emt = expf(-(Bt + mx));
            __syncthreads();
            ml::f32x16 o0 = {}, o1 = {}; float dsum = 0.f;
            const int jlo = dir ? (tb >> 1) : 0, jhi = dir ? 1 : (tb >> 1);
            for (int j = jlo; j <= jhi; ++j) {
                ml::f32x16 p0 = {}, p1 = {};
                const LAS char* Kt = Kimg + j * 64 * 256;
                const bf16* qp = qbase; asm volatile("" : "+v"(qp));
                ml::bf16x8 qr[8];
#pragma unroll
                for (int d0 = 0; d0 < 8; ++d0) qr[d0] = *(const ml::bf16x8*)(qp + d0 * 16);
#pragma unroll
                for (int d0 = 0; d0 < 8; ++d0) { const int cb = (d0 * 16 + hi * 8) * 2;
                    const ml::bf16x8 k0 = *(const LAS ml::bf16x8*)(Kt + r32 * 256 + (cb ^ ((r32 & 7) << 4)));
                    const ml::bf16x8 k1 = *(const LAS ml::bf16x8*)(Kt + (32 + r32) * 256 + (cb ^ ((r32 & 7) << 4)));
                    p0 = __builtin_amdgcn_mfma_f32_32x32x16_bf16(k0, qr[d0], p0, 0, 0, 0);
                    p1 = __builtin_amdgcn_mfma_f32_32x32x16_bf16(k1, qr[d0], p1, 0, 0, 0); }
#pragma unroll
                for (int r = 0; r < 16; ++r) { const int s0 = 64 * j + ml::crow(r, hi), s1 = s0 + 32;
                    const float e0 = __builtin_amdgcn_exp2f(btl + bsT[s0]), e1 = __builtin_amdgcn_exp2f(btl + bsT[s1]);
                    const bool v0 = dir ? (s0 >= tl) : (s0 <= tl), v1 = dir ? (s1 >= tl) : (s1 <= tl);
                    p0[r] = v0 ? p0[r] * e0 : 0.f; p1[r] = v1 ? p1[r] * e1 : 0.f; dsum += p0[r] + p1[r]; }
                ml::bf16x8 pa0, pa1, pa2, pa3;
#define ML_PK4(P, BASE, OUT) do { unsigned a0 = ml::cvtpk(P[BASE + 0], P[BASE + 1]), a1 = ml::cvtpk(P[BASE + 2], P[BASE + 3]);   \
    unsigned b0 = ml::cvtpk(P[BASE + 4], P[BASE + 5]), b1 = ml::cvtpk(P[BASE + 6], P[BASE + 7]);                              \
    auto r0 = __builtin_amdgcn_permlane32_swap(a0, b0, false, false); auto r1 = __builtin_amdgcn_permlane32_swap(a1, b1, false, false); \
    ml::u32x4 w = {r0[0], r1[0], r0[1], r1[1]}; OUT = __builtin_bit_cast(ml::bf16x8, w); } while (0)
                ML_PK4(p0, 0, pa0); ML_PK4(p0, 8, pa1); ML_PK4(p1, 0, pa2); ML_PK4(p1, 8, pa3);
#undef ML_PK4
                const LAS char* Vt = Vimg + j * 16384 + rdb;
                o0 = __builtin_amdgcn_mfma_f32_32x32x16_bf16(pa0, ml::trfrag(Vt, 2 * eh, 0), o0, 0, 0, 0); o1 = __builtin_amdgcn_mfma_f32_32x32x16_bf16(pa0, ml::trfrag(Vt, 2 * eh + 1, 0), o1, 0, 0, 0);
                o0 = __builtin_amdgcn_mfma_f32_32x32x16_bf16(pa1, ml::trfrag(Vt, 2 * eh, 1), o0, 0, 0, 0); o1 = __builtin_amdgcn_mfma_f32_32x32x16_bf16(pa1, ml::trfrag(Vt, 2 * eh + 1, 1), o1, 0, 0, 0);
                o0 = __builtin_amdgcn_mfma_f32_32x32x16_bf16(pa2, ml::trfrag(Vt, 2 * eh, 2), o0, 0, 0, 0); o1 = __builtin_amdgcn_mfma_f32_32x32x16_bf16(pa2, ml::trfrag(Vt, 2 * eh + 1, 2), o1, 0, 0, 0);
                o0 = __builtin_amdgcn_mfma_f32_32x32x16_bf16(pa3, ml::trfrag(Vt, 2 * eh, 3), o0, 0, 0, 0); o1 = __builtin_amdgcn_mfma_f32_32x32x16_bf16(pa3, ml::trfrag(Vt, 2 * eh + 1, 3), o1, 0, 0, 0);
            }
            float qn = 0.f;
            const bf16* qp2 = qbase; asm volatile("" : "+v"(qp2));
#pragma unroll
            for (int kk = 0; kk < 8; ++kk) {
                const ml::bf16x8 qv = *(const ml::bf16x8*)(qp2 + kk * 16);
                float f[8];
#pragma unroll
                for (int i = 0; i < 8; ++i) { f[i] = bf2f((bf16)qv[i]); qn += f[i] * nT[16 * kk + 8 * hi + i]; f[i] *= iw; }
                const ml::bf16x8 qs = ml::pack8(f);
                const LAS char* Ct = Cimg + (kk >> 2) * 16384 + rdb;
                o0 = __builtin_amdgcn_mfma_f32_32x32x16_bf16(qs, ml::trfrag(Ct, 2 * eh, kk & 3), o0, 0, 0, 0);
                o1 = __builtin_amdgcn_mfma_f32_32x32x16_bf16(qs, ml::trfrag(Ct, 2 * eh + 1, kk & 3), o1, 0, 0, 0);
            }
            const float den = ml::hsum2(dsum) + iw * ml::hsum2(qn);
            const float rden = 1.f / fmaxf(fabsf(den), emt);
            if (hi == 0) wsc[r32] = rden;
#pragma unroll
            for (int r = 0; r < 16; ++r) { const float rd = wsc[ml::crow(r, hi)]; hs0[r] += o0[r] * rd; hs1[r] += o1[r] * rd; }
        }
        __syncthreads();
#pragma unroll
        for (int r = 0; r < 16; ++r) { const int row = 32 * tb + ml::crow(r, hi); Hb[row * 128 + 32 * (2 * eh) + r32] = hs0[r]; Hb[row * 128 + 32 * (2 * eh + 1) + r32] = hs1[r]; }
        float mo0[16], mo1[16];
#pragma unroll
        for (int i = 0; i < 16; ++i) { const size_t tp = (size_t)co * CH + 16 * F.wave + i; mo0[i] = bf2f(RAW[tp * DINP + C_MO + h * 128 + lane]); mo1[i] = bf2f(RAW[tp * DINP + C_MO + h * 128 + 64 + lane]); }
        const float hn0 = hn[h * 128 + lane], hn1 = hn[h * 128 + 64 + lane];
        __syncthreads();
#pragma unroll
        for (int i = 0; i < 16; ++i) { const int row = 16 * F.wave + i; const size_t tp = (size_t)co * CH + row;
            float v0 = Hb[row * 128 + lane], v1 = Hb[row * 128 + 64 + lane];
            const float mu = wave_sum(v0 + v1) * (1.f / 128.f); v0 -= mu; v1 -= mu;
            const float rstd = 1.f / sqrtf(wave_sum(v0 * v0 + v1 * v1) * (1.f / 128.f) + 1e-5f);
            MIX[tp * D + 1536 + h * 128 + lane] = f2bf(sigmoidf(mo0[i]) * v0 * rstd * hn0);
            MIX[tp * D + 1536 + h * 128 + 64 + lane] = f2bf(sigmoidf(mo1[i]) * v1 * rstd * hn1); }
        __syncthreads();
    }
}
template <int ST>
__device__ __forceinline__ void m2_scan(float* p, const float* GC, const float* MC, float* MP, int dh, bool wm) {
    float C = 0.f, m = 0.f;
    for (int b = 0; b < 2; ++b) {
        float kv[32]; float* pb = p + (size_t)b * 32 * ST;
#pragma unroll
        for (int cl = 0; cl < 32; ++cl) kv[cl] = pb[(size_t)cl * ST];
#pragma unroll
        for (int cl = 0; cl < 32; ++cl) { const float g = GC[dh * 64 + b * 32 + cl], mc = MC[dh * 64 + b * 32 + cl];
            const float mn = fmaxf(g + m, mc), dec = expf(g + m - mn), ad = expf(mc - mn);
            if (wm) MP[dh * 64 + b * 32 + cl] = m;
            const float cin = C; C = dec * C + ad * kv[cl]; kv[cl] = cin; m = mn; }
#pragma unroll
        for (int cl = 0; cl < 32; ++cl) pb[(size_t)cl * ST] = kv[cl];
    }
}
__device__ __forceinline__ void ph_m2(const Frame& F) {
    float* KV = (float*)(F.ws + O_KV); float* KS = (float*)(F.ws + O_KS);
    const float* GC = (const float*)(F.ws + O_CHS); const float* MC = GC + 512; float* MP = (float*)(F.ws + O_CHS) + 1024;
    const int gt = F.bid * NTHR + F.tid, ngt = F.nblk * NTHR;
    for (int it = gt; it < 8 * 16384; it += ngt) { const int dh = (int)(it >> 14), de = (int)(it & 16383); m2_scan<16384>(KV + ((size_t)(dh * 64) << 14) + de, GC, MC, MP, dh, false); }
    for (int it = ngt - 1 - gt; it < 8 * 128; it += ngt) { const int dh = (int)(it >> 7), d = (int)(it & 127); m2_scan<128>(KS + (size_t)dh * 64 * 128 + d, GC, MC, MP, dh, d == 0); }
}
template <int MODE  , bool WRITE_U, bool ROUTE>
__device__ __forceinline__ void ph_ln(const Frame& F, const float* X, const bf16* R  , const float* gate, const float* lg, const float* lb, float* XO,
                                      const float* shift2, const float* scale2, bf16* U, const float* rw) {
    int* TE = (int*)(F.ws + O_TOPK); float* TW = (float*)(F.ws + O_TOPK + 65536); int* TR = (int*)(F.ws + O_TOPK + 131072); const int* SLOT = (const int*)(F.ws + O_TOPK + 196608);
    unsigned* CNT = (unsigned*)(F.ws + O_CTL) + CW_CNT;
    pg8::DownPlan dplan; dplan.T = 0; dplan.tfull = 0; dplan.tt = 0; dplan.f = 1; const bf16* PART = (const bf16*)(F.ws + O_XS);
    if (MODE == 1) { const Seg seg = load_seg(CNT); int ts[9];
#pragma unroll
        for (int i = 0; i < 9; ++i) ts[i] = seg.start[i] >> 8;
        dplan = pg8::down_plan(ts, F.nblk); }
    LAS int* rl = (LAS int*)F.lds; const int NIT = (S + F.ngw - 1) / F.ngw; int kit = 0;
    LAS f32x4* rwl = (LAS f32x4*)(F.lds + 65536);
    LAS f32x4* pl = (LAS f32x4*)(F.lds + 8192);
    for (int q = F.tid; q < 512; q += NTHR) { pl[q] = *(const f32x4*)(gate + 4 * q); pl[512 + q] = *(const f32x4*)(lg + 4 * q); pl[1024 + q] = *(const f32x4*)(lb + 4 * q);
        if (WRITE_U) { pl[1536 + q] = *(const f32x4*)(scale2 + 4 * q); pl[2048 + q] = *(const f32x4*)(shift2 + 4 * q); } }
    if (!ROUTE) __syncthreads();
    if (ROUTE) { for (int i = F.tid; i < NWAVES * NIT * 2; i += NTHR) rl[i] = -1;
        for (int q = F.tid; q < 4096; q += NTHR) { const int ln = q & 63, hf = (q >> 6) & 1, c = (q >> 7) & 3, i = q >> 9; rwl[q] = *(const f32x4*)(rw + (size_t)(4 * ln + 256 * i + c) * 8 + 4 * hf); }
        __syncthreads(); }
    int s0n = 0, s1n = 0; float w0n = 0.f, w1n = 0.f;
    if (MODE == 1) { const int tp = F.gw < S ? F.gw : S - 1; s0n = SLOT[2 * tp]; s1n = SLOT[2 * tp + 1]; w0n = TW[2 * tp]; w1n = TW[2 * tp + 1]; }
    for (int t = F.gw; t < S; t += F.ngw) {
        int j0 = 4 * F.lane; asm volatile("" : "+v"(j0));
        float y[32]; float s = 0.f;
        const bf16* r0 = R + (size_t)t * D; const bf16* r1 = r0; const bf16* q0 = PART; const bf16* q1 = PART; float w0 = 1.f, w1 = 0.f; int n0 = 1, n1 = 1;
        if (MODE == 1) { const int s0 = s0n, s1 = s1n; w0 = w0n; w1 = w1n;
            { const int tn = t + F.ngw < S ? t + F.ngw : t; s0n = SLOT[2 * tn]; s1n = SLOT[2 * tn + 1]; w0n = TW[2 * tn]; w1n = TW[2 * tn + 1]; }
            if (dplan.f > 1 && (s0 >> 8) >= dplan.tfull) { q0 = PART + ((size_t)(((s0 >> 8) - dplan.tfull) * dplan.f) * 256 + (s0 & 255)) * D; n0 = dplan.f; } else r0 = R + (size_t)s0 * D;
            if (dplan.f > 1 && (s1 >> 8) >= dplan.tfull) { q1 = PART + ((size_t)(((s1 >> 8) - dplan.tfull) * dplan.f) * 256 + (s1 & 255)) * D; n1 = dplan.f; } else r1 = R + (size_t)s1 * D; }
#pragma unroll
        for (int i = 0; i < 8; ++i) { const int j = j0 + 256 * i; const f32x4 x = *(const f32x4*)(X + (size_t)t * D + j), g = pl[(j0 >> 2) + 64 * i];
            f32x4 r;
            if (MODE != 1 || n0 == 1) r = ld4bf(r0 + j); else { r = ld4bf(q0 + j); for (int q = 1; q < n0; ++q) r += ld4bf(q0 + (size_t)q * 256 * D + j); }
            if (MODE == 1) { f32x4 rb; if (n1 == 1) rb = ld4bf(r1 + j); else { rb = ld4bf(q1 + j); for (int q = 1; q < n1; ++q) rb += ld4bf(q1 + (size_t)q * 256 * D + j); }
                r = r * w0 + rb * w1; }
            y[4 * i + 0] = ALPHA * x.x + g.x * r.x; y[4 * i + 1] = ALPHA * x.y + g.y * r.y; y[4 * i + 2] = ALPHA * x.z + g.z * r.z; y[4 * i + 3] = ALPHA * x.w + g.w * r.w;
            s += (y[4 * i] + y[4 * i + 1]) + (y[4 * i + 2] + y[4 * i + 3]); }
        const float mu = wave_sum(s) * (1.f / D); float q = 0.f;
#pragma unroll
        for (int i = 0; i < 32; ++i) { y[i] -= mu; q += y[i] * y[i]; }
        const float rstd = 1.f / sqrtf(wave_sum(q) * (1.f / D) + 1e-5f);
        float lg8[8];
#pragma unroll
        for (int e = 0; e < 8; ++e) lg8[e] = 0.f;
#pragma unroll
        for (int i = 0; i < 8; ++i) { const int j = j0 + 256 * i; const f32x4 g = pl[512 + (j0 >> 2) + 64 * i], b = pl[1024 + (j0 >> 2) + 64 * i];
            f32x4 o = {y[4 * i] * rstd * g.x + b.x, y[4 * i + 1] * rstd * g.y + b.y, y[4 * i + 2] * rstd * g.z + b.z, y[4 * i + 3] * rstd * g.w + b.w};
            __builtin_nontemporal_store(o, (f32x4*)(XO + (size_t)t * D + j));
            if (WRITE_U) { const f32x4 sc = pl[1536 + (j0 >> 2) + 64 * i], sh = pl[2048 + (j0 >> 2) + 64 * i];
                const f32x4 u = {o.x * (1.f + sc.x) + sh.x, o.y * (1.f + sc.y) + sh.y, o.z * (1.f + sc.z) + sh.z, o.w * (1.f + sc.w) + sh.w};
                v2u w; w.x = (unsigned)f2bf(u.x) | ((unsigned)f2bf(u.y) << 16); w.y = (unsigned)f2bf(u.z) | ((unsigned)f2bf(u.w) << 16);
                *(v2u*)(U + (size_t)t * D + j) = w;
                if (ROUTE) {
#pragma unroll
                    for (int c = 0; c < 4; ++c) { const float uv = c == 0 ? u.x : c == 1 ? u.y : c == 2 ? u.z : u.w; const f32x4 ra = rwl[((i * 4 + c) * 2 + 0) * 64 + F.lane], rb = rwl[((i * 4 + c) * 2 + 1) * 64 + F.lane];
                        lg8[0] += uv * ra.x; lg8[1] += uv * ra.y; lg8[2] += uv * ra.z; lg8[3] += uv * ra.w; lg8[4] += uv * rb.x; lg8[5] += uv * rb.y; lg8[6] += uv * rb.z; lg8[7] += uv * rb.w; } } }
        }
        if (ROUTE) {
#pragma unroll
            for (int e = 0; e < 8; ++e) lg8[e] = wave_sum(lg8[e]);
            int i0 = 0; float v0 = lg8[0];
#pragma unroll
            for (int e = 1; e < 8; ++e) if (lg8[e] > v0) { v0 = lg8[e]; i0 = e; }
            int i1 = -1; float v1 = -INFINITY;
#pragma unroll
            for (int e = 0; e < 8; ++e) if (e != i0 && lg8[e] > v1) { v1 = lg8[e]; i1 = e; }
            if (F.lane == 0) { const float p0 = 1.f / (1.f + expf(v1 - v0)); TE[2 * t] = i0; TE[2 * t + 1] = i1; TW[2 * t] = p0; TW[2 * t + 1] = 1.f - p0;
                rl[(F.wave * NIT + kit) * 2] = i0; rl[(F.wave * NIT + kit) * 2 + 1] = i1; }
            ++kit;
        }
    }
    if (ROUTE) {
        __syncthreads();
        const int n = NWAVES * NIT * 2;
        for (int i = F.tid; i < n; i += NTHR) { const int e = rl[i];
            if (e >= 0) { int r = 0; for (int q = 0; q < i; ++q) r += (rl[q] == e) ? 1 : 0;
                const int w = i / (2 * NIT), k = (i >> 1) % NIT, t = F.bid * NWAVES + w + k * F.ngw; TR[2 * t + (i & 1)] = r; } }
        if (F.tid < 8) { int cnt = 0; for (int q = 0; q < n; ++q) cnt += (rl[q] == F.tid) ? 1 : 0; ((int*)(F.ws + O_BCNT))[F.bid * 8 + F.tid] = cnt; }
        __syncthreads();
    }
}
__device__ __forceinline__ void ph_gather(const Frame& F) {
    const int* TE = (const int*)(F.ws + O_TOPK); const int* TR = (const int*)(F.ws + O_TOPK + 131072); int* SLOT = (int*)(F.ws + O_TOPK + 196608);
    LAS int* sh = (LAS int*)F.lds; const int* BCNT = (const int*)(F.ws + O_BCNT);
    if (F.tid < 16) sh[F.tid] = 0;
    __syncthreads();
    for (int i = F.tid; i < F.nblk * 8; i += NTHR) { const int v = BCNT[i], b = i >> 3, e = i & 7; atomicAdd((int*)(sh + 8 + e), v); if (b < F.bid) atomicAdd((int*)(sh + e), v); }
    __syncthreads();
    int base[8]; unsigned tot[8];
#pragma unroll
    for (int e = 0; e < 8; ++e) { base[e] = __builtin_amdgcn_readfirstlane(sh[e]); tot[e] = (unsigned)__builtin_amdgcn_readfirstlane(sh[8 + e]); }
    if (F.bid == 0 && F.tid < 8) ((unsigned*)(F.ws + O_CTL) + CW_CNT)[F.tid] = (unsigned)sh[8 + F.tid];
    Seg seg; { int acc = 0;
#pragma unroll
        for (int e = 0; e < 8; ++e) { seg.start[e] = acc; acc += ((int)tot[e] + 255) & ~255; }
        seg.start[8] = acc; }
    __syncthreads();
    const bf16* U = (const bf16*)(F.ws + O_U); bf16* XS = (bf16*)(F.ws + O_XS);
    for (int t = F.gw; t < S; t += F.ngw) {
        v4u r[4];
#pragma unroll
        for (int i = 0; i < 4; ++i) r[i] = *(const v4u*)(U + (size_t)t * D + 8 * F.lane + 512 * i);
#pragma unroll
        for (int k = 0; k < 2; ++k) { const int e = TE[2 * t + k]; int slot = 0;
#pragma unroll
            for (int i = 0; i < 8; ++i) if (i == e) slot = seg.start[i] + base[i];
            slot += TR[2 * t + k]; if (F.lane == 0) SLOT[2 * t + k] = slot;
#pragma unroll
            for (int i = 0; i < 4; ++i) *(v4u*)(XS + (size_t)slot * D + 8 * F.lane + 512 * i) = r[i]; }
    }
}

constexpr int LDS_BYTES = 147456, LDSCTL_OFF = 131072;
constexpr int NPH_LAYER = 12, NPH = 1 + 2 * NPH_LAYER;
#ifndef N_LAUNCH_MODE
#define N_LAUNCH_MODE 1
#endif
__device__ __forceinline__ unsigned char* opq(unsigned char* p) { asm volatile("" : "+s"(p)); return p; }
#define IN(k) (lo <= (k) && (k) < hi)
#define SEAM(k, kn) do { if (IN(k) && IN(kn)) xcd_barrier(bar); } while (0)
#ifndef PROBE_MASK
#define PROBE_MASK 0u
#endif
#define PHASE(k) if (IN(k)) for (int rep_ = 0; rep_ < ((((PROBE_MASK) >> (k)) & 1u) ? 2 : 1); ++rep_) for (Frame G = F, *once_ = &G; once_; once_ = nullptr) if ((G.ws = opq(F.ws)), (rep_ ? __syncthreads() : (void)0), true)
template <int L>
__device__ __forceinline__ void run_layer(const Frame& F, const Args& a, const int lo, const int hi, const XcdBarrier& bar) {
    constexpr int P = 1 + L * NPH_LAYER; constexpr int l = L;
    if (L == 0) PHASE(P + 0) { const float* md = (const float*)(G.ws + O_MOD) + L * NMOD; ph_modulate(G, L ? (const float*)(G.ws + O_XB) : a.in[0], md, md + D, (bf16*)(G.ws + O_U)); }
    if (L == 0) SEAM(P + 0, P + 1);
    PHASE(P + 1) { fgemm(G, (const bf16*)(G.ws + O_U), (const bf16*)(G.ws + O_WIN) + (size_t)L * DINP * D, S, DINP, D, pg8::EpiBf16Gate{(bf16*)(G.ws + O_RAW), DINP, (float*)(G.ws + O_GATES), C_MG}); }
    SEAM(P + 1, P + 2);
    PHASE(P + 2) { ph_post(G, a, l); ph_m0_fast(G, LIN(10)); }
    SEAM(P + 2, P + 3);
    PHASE(P + 3) { fgemm(G, (const bf16*)(G.ws + O_CQ), (const bf16*)(G.ws + O_WUQ) + (size_t)L * 768 * 512, S, 768, 512, pg8::EpiBf16{(bf16*)(G.ws + O_RAWQ), 768});
                   fgemm(G, (const bf16*)(G.ws + O_CKV), (const bf16*)(G.ws + O_WUKV) + (size_t)L * 1024 * 256, S, 1024, 256, pg8::EpiBf16{(bf16*)(G.ws + O_RAWKV), 1024}, G.nblk / 2);
                   ph_m1_fast(G); }
    SEAM(P + 3, P + 4);
    PHASE(P + 4) { ph_mlapost(G, L); ph_m2(G); }
    SEAM(P + 4, P + 5);
    PHASE(P + 5) { if (mla_bounds_ok(G)) ph_fattn<true>(G, a, L, LIN(3), LIN(4)); else ph_fattn<false>(G, a, L, LIN(3), LIN(4)); ph_m3_fast(G, LIN(11)); }
    SEAM(P + 5, P + 6);
    PHASE(P + 6) { fgemm(G, (const bf16*)(G.ws + O_MIX), (const bf16*)(G.ws + O_WOUT) + (size_t)L * D * D, S, D, D, pg8::EpiBf16{(bf16*)(G.ws + O_RAW), D}); }
    SEAM(P + 6, P + 7);
    PHASE(P + 7) { const float* md = (const float*)(G.ws + O_MOD) + L * NMOD; const float* Xin = L ? (const float*)(G.ws + O_XB) : a.in[0];
                   ph_ln<0, true, L == 1>(G, Xin, (const bf16*)(G.ws + O_RAW), md + 2 * D, LIN(13), LIN(14), (float*)(G.ws + O_XA), md + 3 * D, md + 4 * D, (bf16*)(G.ws + O_U), L ? a.in[37] : nullptr); }
    SEAM(P + 7, P + 8);
    if (L == 0) {
        PHASE(P + 8) { fgemm(G, (const bf16*)(G.ws + O_U), (const bf16*)(G.ws + O_WGU0), S, 2 * FF0, D, pg8::EpiSwiglu{(bf16*)(G.ws + O_H), FF0}); }
        SEAM(P + 8, P + 9);
        PHASE(P + 9) { fgemm(G, (const bf16*)(G.ws + O_H), (const bf16*)(G.ws + O_WD0), S, D, FF0, pg8::EpiBf16{(bf16*)(G.ws + O_RAW + 64 * MiB), D}); }
        SEAM(P + 9, P + 11);
        PHASE(P + 11) { const float* md = (const float*)(G.ws + O_MOD) + L * NMOD;
                        ph_ln<0, true, false>(G, (const float*)(G.ws + O_XA), (const bf16*)(G.ws + O_RAW + 64 * MiB), md + 5 * D, a.in[20], a.in[21], (float*)(G.ws + O_XB), md + NMOD, md + NMOD + D, (bf16*)(G.ws + O_U), nullptr); }
    } else {
        PHASE(P + 8) { ph_gather(G); }
        SEAM(P + 8, P + 9);
        PHASE(P + 9) { const Seg seg = load_seg((const unsigned*)(G.ws + O_CTL) + CW_CNT);
                        fgemm_grouped(G, (const bf16*)(G.ws + O_XS), (const bf16*)(G.ws + O_WGU1), 2 * FF1, D, (size_t)2 * FF1 * D * 2, seg, pg8::EpiSwiglu{(bf16*)(G.ws + O_H), FF1}); }
        SEAM(P + 9, P + 10);
        PHASE(P + 10) { const Seg seg = load_seg((const unsigned*)(G.ws + O_CTL) + CW_CNT);
                        pg8::DownOrder So; So.G = G.nblk; So.c = G.bid;
#pragma unroll
                        for (int i = 0; i < 9; ++i) So.tstart[i] = seg.start[i] >> 8;
                        So.p = pg8::down_plan(So.tstart, G.nblk);
                        { So.tail = false; pg8::Gemm g{(const bf16*)(G.ws + O_H), (const bf16*)(G.ws + O_WD1), MPAD, D, FF1, (size_t)D * FF1 * 2, FF1};
                          pg8::gemm_phase<pg8::EpiBf16, pg8::DownOrder, true, true>(G.lds, g, So, pg8::EpiBf16{(bf16*)(G.ws + O_RAW), D}); }
                        if (So.p.f > 1) { So.tail = true; pg8::Gemm g{(const bf16*)(G.ws + O_H), (const bf16*)(G.ws + O_WD1), MPAD, D, FF1 / So.p.f, (size_t)D * FF1 * 2, FF1};
                          pg8::gemm_phase<pg8::EpiBf16Part, pg8::DownOrder, true, true>(G.lds, g, So, pg8::EpiBf16Part{(pg8::bf16_t*)(G.ws + O_XS), D, So.p.tfull, So.p.f}); } }
        SEAM(P + 10, P + 11);
        PHASE(P + 11) { const float* md = (const float*)(G.ws + O_MOD) + L * NMOD;
                        ph_ln<1, false, false>(G, (const float*)(G.ws + O_XA), (const bf16*)(G.ws + O_RAW), md + 5 * D, a.in[41], a.in[42], a.out, nullptr, nullptr, nullptr, nullptr); }
    }
}
__global__ void __launch_bounds__(NTHR, 2) fwd(Args a) {
    extern __shared__ __attribute__((aligned(16))) unsigned char lds_raw[];
    Frame F;
    F.lds = (LAS unsigned char*)lds_raw; F.ws = a.ws;
    F.tid = threadIdx.x; F.lane = F.tid & 63; F.wave = __builtin_amdgcn_readfirstlane(F.tid >> 6);
    F.bid = blockIdx.x; F.nblk = gridDim.x; F.gw = F.bid * NWAVES + F.wave; F.ngw = F.nblk * NWAVES;
    const int lo = a.ph_lo, hi = a.ph_hi;
    if (F.tid < 64) ((LAS unsigned*)(F.lds + LDSCTL_OFF))[F.tid] = 0u;
    __syncthreads();
    XcdBarrier bar; bar.bar = (unsigned*)(a.ws + O_CTL) + CW_BAR; bar.x = 0; bar.st = nullptr;
    if (hi - lo > 1) bar = xcd_barrier_post((unsigned*)(a.ws + O_CTL) + CW_BAR, (volatile LAS unsigned*)(F.lds + LDSCTL_OFF + 32));
    PHASE(0) { ph_mod_fast(G, a); ph_rope_table(G); ph_convert(G, a, 0, CVT_EARLY); }
    SEAM(0, 1);
    run_layer<0>(F, a, lo, hi, bar);
    SEAM(1 + 11, 1 + NPH_LAYER + 1);
    run_layer<1>(F, a, lo, hi, bar);
}

extern "C" void kernel_launch(void* const* d_in, const int* in_sizes, int n_in, void* d_out, int out_size, void* d_ws, size_t ws_size, hipStream_t stream) {
    static int grid = 0;
    if (grid == 0) {
        if (n_in != 43 || out_size != S * D || ws_size < O_END) { fprintf(stderr, "kernel_launch: unexpected shapes: n_in %d out %d ws %zu (need %zu)\n", n_in, out_size, ws_size, (size_t)O_END); grid = -1; return; }
        int dev = 0, cus = 0;
        if (hipGetDevice(&dev) != hipSuccess || hipDeviceGetAttribute(&cus, hipDeviceAttributeMultiprocessorCount, dev) != hipSuccess) { grid = -1; return; }
        if (hipFuncSetAttribute((const void*)fwd, hipFuncAttributeMaxDynamicSharedMemorySize, LDS_BYTES) != hipSuccess) { fprintf(stderr, "kernel_launch: hipFuncSetAttribute failed\n"); grid = -1; return; }
        int per_cu = 0; (void)hipOccupancyMaxActiveBlocksPerMultiprocessor(&per_cu, (const void*)fwd, NTHR, LDS_BYTES); (void)hipGetLastError();
        if (per_cu < 1) fprintf(stderr, "kernel_launch: occupancy query reports %d workgroups per CU\n", per_cu);
        grid = cus;
    }
    if (grid < 0) return;
    (void)hipMemsetAsync((char*)d_ws + O_CTL, 0, MiB, stream);
    Args a{};
    for (int i = 0; i < 43; ++i) a.in[i] = (const float*)d_in[i];
    a.out = (float*)d_out; a.ws = (unsigned char*)d_ws;
#if N_LAUNCH_MODE == 1
    a.ph_lo = 0; a.ph_hi = NPH;
    hipLaunchKernelGGL(fwd, dim3(grid), dim3(NTHR), LDS_BYTES, stream, a);
#else
    for (int ph = 0; ph < NPH; ++ph) {
        if (ph == 1 + 10 || ph == 1 + NPH_LAYER) continue;
        a.ph_lo = ph; a.ph_hi = ph + 1;
        hipLaunchKernelGGL(fwd, dim3(grid), dim3(NTHR), LDS_BYTES, stream, a);
    }
#endif
}
```
